# Optimizing an MI355X kernel written in HIP

```python
import jax, jax.numpy as jnp
from jax import lax
import numpy as np

D_MODEL = 1024
BATCH = 4
SEQ = 8192
DEPTH = 1

RET_HEADS = D_MODEL // 256
RET_QK_DIM = D_MODEL
RET_V_DIM = 2 * D_MODEL
RET_HEAD_QK = RET_QK_DIM // RET_HEADS
RET_HEAD_V = RET_V_DIM // RET_HEADS
RET_CHUNK = 128
ROPE_BASE = 10000.0
GN_EPS = 1e-5
CONV_DIM = D_MODEL
CONV_WIDTH = 31
LN_EPS = 1e-5
RMS_EPS = 1e-6
IN_SPLITS = (RET_QK_DIM, RET_QK_DIM, RET_V_DIM, RET_V_DIM, CONV_DIM, CONV_DIM, CONV_DIM, D_MODEL, D_MODEL)
IN_WIDTH = sum(IN_SPLITS)

kernel_name = "hybrid_retention_conformer_gated_block"


def rmsnorm(x, g):
    xf = x.astype(jnp.float32)
    y = xf * lax.rsqrt(jnp.mean(xf * xf, axis=-1, keepdims=True) + RMS_EPS)
    return (y * g.astype(jnp.float32)).astype(x.dtype)


def layernorm(x, g, b):
    xf = x.astype(jnp.float32)
    mu = jnp.mean(xf, axis=-1, keepdims=True)
    var = jnp.mean(jnp.square(xf - mu), axis=-1, keepdims=True)
    y = (xf - mu) * lax.rsqrt(var + LN_EPS)
    return (y * g.astype(jnp.float32) + b.astype(jnp.float32)).astype(x.dtype)


def head_groupnorm(o):
    of = o.astype(jnp.float32)
    mu = jnp.mean(of, axis=-1, keepdims=True)
    var = jnp.mean(jnp.square(of - mu), axis=-1, keepdims=True)
    return (of - mu) * lax.rsqrt(var + GN_EPS)


def rotary(t, positions):
    dh = t.shape[-1]
    half = dh // 2
    inv_freq = ROPE_BASE ** (-jnp.arange(half, dtype=jnp.float32) / half)
    ang = positions.astype(jnp.float32)[..., None] * inv_freq
    cos = jnp.cos(ang)[:, :, None, :]
    sin = jnp.sin(ang)[:, :, None, :]
    t1, t2 = t[..., :half], t[..., half:]
    return jnp.concatenate([t1 * cos - t2 * sin, t1 * sin + t2 * cos], axis=-1)


def retention_chunkwise(q, k, v):
    B, S, H, dk = q.shape
    dv = v.shape[-1]
    C = RET_CHUNK
    N = S // C
    log_g = jnp.log1p(-jnp.exp2(-5.0 - jnp.arange(H, dtype=jnp.float32)))
    idx = jnp.arange(C, dtype=jnp.float32)
    diff = idx[:, None] - idx[None, :]
    causal = diff >= 0
    decay_mask = jnp.where(causal, jnp.exp(log_g[:, None, None] * jnp.where(causal, diff, 0.0)), 0.0)
    xi = jnp.exp(log_g[:, None] * (idx + 1.0))
    zeta = jnp.exp(log_g[:, None] * (C - 1.0 - idx))
    g_chunk = jnp.exp(log_g * C)

    def to_chunks(t):
        return t.reshape(B, N, C, H, t.shape[-1]).transpose(1, 0, 3, 2, 4)

    def step(state, inp):
        qc, kc, vc = inp
        scores = jnp.einsum('bhid,bhjd->bhij', qc, kc) * decay_mask[None]
        inner = jnp.einsum('bhij,bhje->bhie', scores, vc)
        cross = jnp.einsum('bhid,bhde->bhie', qc, state) * xi[None, :, :, None]
        new_state = state * g_chunk[None, :, None, None] + jnp.einsum(
            'bhjd,bhje->bhde', kc * zeta[None, :, :, None], vc)
        return new_state, inner + cross

    state0 = jnp.zeros((B, H, dk, dv), jnp.float32)
    _, o = lax.scan(step, state0, (to_chunks(q), to_chunks(k), to_chunks(v)))
    return o.transpose(1, 0, 3, 2, 4).reshape(B, S, H, dv)


def causal_depthwise_conv(u, w, b):
    out = lax.conv_general_dilated(
        u, w[:, None, :].astype(u.dtype), window_strides=(1,),
        padding=[(CONV_WIDTH - 1, 0)],
        dimension_numbers=('NWC', 'WIO', 'NWC'),
        feature_group_count=u.shape[-1])
    return out + b.astype(u.dtype)


def setup_inputs(seed: int = 0) -> dict:
    key = jax.random.key(seed)
    ks = jax.random.split(key, 16)
    f32 = jnp.float32
    x = jax.random.normal(ks[0], (BATCH, SEQ, D_MODEL), f32)
    c = jax.random.normal(ks[1], (BATCH, D_MODEL), f32)
    offsets = jax.random.randint(ks[2], (BATCH, 1), 0, 4096, dtype=jnp.int32)
    positions = offsets + jnp.arange(SEQ, dtype=jnp.int32)[None, :]
    w_ada = jax.random.normal(ks[3], (DEPTH, D_MODEL, 3 * D_MODEL), f32) * (0.1 * D_MODEL ** -0.5)
    b_ada = jax.random.normal(ks[4], (DEPTH, 3 * D_MODEL), f32) * 0.02
    pre_norm_g = 1.0 + 0.05 * jax.random.normal(ks[5], (DEPTH, D_MODEL), f32)
    w_in = jax.random.normal(ks[6], (DEPTH, D_MODEL, IN_WIDTH), f32) * D_MODEL ** -0.5
    conv_w = jax.random.normal(ks[7], (DEPTH, CONV_WIDTH, CONV_DIM), f32) * CONV_WIDTH ** -0.5
    conv_b = jax.random.normal(ks[8], (DEPTH, CONV_DIM), f32) * 0.02
    conv_ln_g = 1.0 + 0.05 * jax.random.normal(ks[9], (DEPTH, CONV_DIM), f32)
    conv_ln_b = jax.random.normal(ks[10], (DEPTH, CONV_DIM), f32) * 0.02
    w_ret_out = jax.random.normal(ks[11], (DEPTH, RET_V_DIM, D_MODEL), f32) * RET_V_DIM ** -0.5
    w_conv_out = jax.random.normal(ks[12], (DEPTH, CONV_DIM, D_MODEL), f32) * CONV_DIM ** -0.5
    w_out = jax.random.normal(ks[13], (DEPTH, D_MODEL, D_MODEL), f32) * D_MODEL ** -0.5
    post_norm_g = 1.0 + 0.05 * jax.random.normal(ks[14], (DEPTH, D_MODEL), f32)
    return {"x": x, "c": c, "positions": positions, "w_ada": w_ada, "b_ada": b_ada,
            "pre_norm_g": pre_norm_g, "w_in": w_in, "conv_w": conv_w, "conv_b": conv_b,
            "conv_ln_g": conv_ln_g, "conv_ln_b": conv_ln_b, "w_ret_out": w_ret_out,
            "w_conv_out": w_conv_out, "w_out": w_out, "post_norm_g": post_norm_g}


def reference(x, c, positions, w_ada, b_ada, pre_norm_g, w_in, conv_w, conv_b,
              conv_ln_g, conv_ln_b, w_ret_out, w_conv_out, w_out, post_norm_g):
    B, S, _ = x.shape
    split_at = [int(v) for v in np.cumsum(IN_SPLITS)[:-1]]
    for l in range(DEPTH):
        mod = c @ w_ada[l] + b_ada[l]
        shift, scale, gate = jnp.split(mod, 3, axis=-1)
        h = rmsnorm(x, pre_norm_g[l]) * (1.0 + scale[:, None, :]) + shift[:, None, :]

        proj = h @ w_in[l]
        q, k, v, z_ret, u_val, u_gate, z_conv, g_a, g_b = jnp.split(proj, split_at, axis=-1)

        qh = rotary(q.reshape(B, S, RET_HEADS, RET_HEAD_QK).astype(jnp.float32), positions)
        kh = rotary(k.reshape(B, S, RET_HEADS, RET_HEAD_QK).astype(jnp.float32), positions) * RET_HEAD_QK ** -0.5
        vh = v.reshape(B, S, RET_HEADS, RET_HEAD_V).astype(jnp.float32)
        ret = head_groupnorm(retention_chunkwise(qh, kh, vh)).reshape(B, S, RET_V_DIM).astype(x.dtype)
        y_a = (ret * jax.nn.silu(z_ret)) @ w_ret_out[l]

        a = u_val * jax.nn.sigmoid(u_gate)
        a = causal_depthwise_conv(a, conv_w[l], conv_b[l])
        a = jax.nn.silu(layernorm(a, conv_ln_g[l], conv_ln_b[l]))
        y_b = (a * jax.nn.silu(z_conv)) @ w_conv_out[l]

        merged = jax.nn.sigmoid(g_a) * y_a + jax.nn.sigmoid(g_b) * y_b
        y = merged @ w_out[l]

        x = x + gate[:, None, :] * rmsnorm(y, post_norm_g[l])
    return x
```

```cpp
#include <hip/hip_runtime.h>
#include <cstdio>
#include <cstdint>
namespace pg8 {
#define PG8_LAS __attribute__((address_space(3)))
typedef unsigned short bf16_t;
typedef short bf16x8 __attribute__((ext_vector_type(8)));
typedef float f32x4 __attribute__((ext_vector_type(4)));
typedef unsigned u32x4 __attribute__((ext_vector_type(4)));
constexpr int BM = 256, BK = 64, HALF = 128, HTB = HALF * BK * 2  , STAGE_BYTES = 8 * HTB, NXCD = 8, WGM = 8;

__host__ __device__ __forceinline__ int lds_byte(int r, int c) { const int st = (r >> 4) * 2 + (c >> 5), rr = r & 15, cc = c & 31, ob = rr * 64 + cc * 2; return st * 1024 + (ob ^ (((ob >> 9) & 1) << 5)); }
__host__ __device__ __forceinline__ void stage_rc(int b, int& R, int& C) { const int st = b / 1024, sb = b % 1024, swz = sb ^ (((sb >> 9) & 1) << 5); R = (st >> 1) * 16 + swz / 64; C = (st & 1) * 32 + (swz % 64) / 2; }
__host__ __device__ __forceinline__ int perm32(int rho) { const int n = rho >> 4, i = rho & 15; return 8 * (i >> 2) + 4 * n + (i & 3); }

struct Unit { int pm, pn; };
struct Gemm { const bf16_t* A; const bf16_t* Bt; int M, N, K; };

struct StaticOrder {
    int nM, nN, nwg, G, c;
    __host__ __device__ void init(int M, int N, int G_, int c_) { nM = M / BM; nN = N / BM; nwg = nM * nN; G = G_; c = c_; }
    __host__ __device__ bool next(int i, Unit& u) const {
        const long L = (long)i * G + c; if (L >= nwg) return false;
        int wgid = (int)L; { const int q = nwg / NXCD, r = nwg % NXCD, xcd = wgid % NXCD, off = wgid / NXCD; wgid = (xcd < r ? xcd * (q + 1) : r * (q + 1) + (xcd - r) * q) + off; }
        const int nig = WGM * nN, gid = wgid / nig, fm = gid * WGM, gsz = (nM - fm) < WGM ? (nM - fm) : WGM;
        u.pm = fm + ((wgid % nig) % gsz); u.pn = (wgid % nig) / gsz; return true;
    }
    __device__ __forceinline__ void a_ready(const Unit&) const {}
    __device__ __forceinline__ void done(const Unit&) const {}
};
__device__ __forceinline__ unsigned cvt_pk_bf16(float lo, float hi) { unsigned r; asm volatile("v_cvt_pk_bf16_f32 %0, %1, %2" : "=v"(r) : "v"(lo), "v"(hi)); return r; }
template <class Epi, class Sched, bool ALIGN_EPI = false, bool SP2 = false>
__device__ __forceinline__ void gemm_phase(PG8_LAS unsigned char* lds, const Gemm g, const Sched& S, const Epi& E) {
    const int tid = threadIdx.x, wid = __builtin_amdgcn_readfirstlane(tid >> 6), lane = tid & 63, wr = wid >> 2, wc = wid & 3, fr = lane & 15, fq = lane >> 4;
    const int K = g.K, nt = K / BK;
    unsigned voffA[2], voffB[2];
#pragma unroll
    for (int i = 0; i < 2; ++i) { int R, C; stage_rc(tid * 16 + i * 8192, R, C); const int Rb = Epi::PERM ? ((R & ~31) + perm32(R & 31)) : R;
        voffA[i] = (unsigned)(R * K + C) * 2u; voffB[i] = (unsigned)(Rb * K + C) * 2u; }
    const size_t kstep = (size_t)(BK * 2);
    const size_t hstep = (size_t)HALF * K * 2;
    const size_t tstep = 2 * hstep;
    const unsigned ldsw = (unsigned)wid * 1024u;
    const int aoff = lds_byte(wr * 64 + fr, fq * 8), boff = lds_byte(wc * 32 + fr, fq * 8);
#define PG8_SA(b, h) (((b) * 2 + (h)) * HTB)
#define PG8_SB(b, h) ((4 + (b) * 2 + (h)) * HTB)
#define PG8_STAGE(bufoff, gbase, voff) do { _Pragma("unroll") for (int _i = 0; _i < 2; ++_i) \
        __builtin_amdgcn_global_load_lds((const unsigned*)((const char*)(gbase) + (voff)[_i]), (PG8_LAS unsigned*)(lds + (bufoff) + ldsw + _i * 8192), 16, 0, 0); } while (0)
#define PG8_LDA(dst, b, h) do { _Pragma("unroll") for (int m = 0; m < 4; ++m) _Pragma("unroll") for (int k = 0; k < 2; ++k) dst[m][k] = *(const PG8_LAS bf16x8*)(lds + PG8_SA(b, h) + aoff + m * 2048 + k * 1024); } while (0)
#define PG8_LDB(dst, b, h) do { _Pragma("unroll") for (int n = 0; n < 2; ++n) _Pragma("unroll") for (int k = 0; k < 2; ++k) dst[n][k] = *(const PG8_LAS bf16x8*)(lds + PG8_SB(b, h) + boff + n * 2048 + k * 1024); } while (0)
#define PG8_MMA(ai, bj, At, Bt) do { __builtin_amdgcn_s_setprio(1); _Pragma("unroll") for (int m = 0; m < 4; ++m) _Pragma("unroll") for (int n = 0; n < 2; ++n) _Pragma("unroll") for (int k = 0; k < 2; ++k) \
        acc[ai][bj][m][n] = __builtin_amdgcn_mfma_f32_16x16x32_bf16(Bt[n][k], At[m][k], acc[ai][bj][m][n], 0, 0, 0); __builtin_amdgcn_s_setprio(0); } while (0)
#define PG8_WAIT_V(n) asm volatile("s_waitcnt vmcnt(" #n ")" ::: "memory")
#define PG8_WAIT_L(n) asm volatile("s_waitcnt lgkmcnt(" #n ")" ::: "memory")
#define PG8_BAR __builtin_amdgcn_s_barrier()
#define PG8_SCHED __builtin_amdgcn_sched_barrier(0)
    Unit cur, nxt; int ui = 0;
    if (!S.next(0, cur)) return;
    f32x4 acc[2][2][4][2];
#pragma unroll
    for (int a = 0; a < 2; ++a)
#pragma unroll
        for (int b = 0; b < 2; ++b)
#pragma unroll
            for (int m = 0; m < 4; ++m)
#pragma unroll
                for (int n = 0; n < 2; ++n) acc[a][b][m][n] = (f32x4){0.f, 0.f, 0.f, 0.f};
    bf16x8 At[4][2], B0[2][2], B1[2][2];
    const char* cA = (const char*)g.A + (size_t)cur.pm * tstep; const char* cB = (const char*)g.Bt + (size_t)cur.pn * tstep;
    S.a_ready(cur);
    if constexpr (SP2) {
        PG8_STAGE(PG8_SB(0, 0), cB, voffB); PG8_STAGE(PG8_SB(0, 1), cB + hstep, voffB); PG8_STAGE(PG8_SA(0, 0), cA, voffA); PG8_STAGE(PG8_SA(0, 1), cA + hstep, voffA);
        if (wr == 1) PG8_BAR;
        PG8_WAIT_V(2); PG8_BAR;
        PG8_STAGE(PG8_SB(1, 0), cB + kstep, voffB); PG8_STAGE(PG8_SA(1, 0), cA + kstep, voffA); PG8_STAGE(PG8_SB(1, 1), cB + hstep + kstep, voffB);
        PG8_WAIT_V(6); PG8_BAR;
    } else {
        PG8_STAGE(PG8_SB(0, 0), cB, voffB); PG8_STAGE(PG8_SA(0, 0), cA, voffA); PG8_STAGE(PG8_SB(0, 1), cB + hstep, voffB); PG8_STAGE(PG8_SA(0, 1), cA + hstep, voffA);
        if (wr == 1) PG8_BAR;
        PG8_WAIT_V(4); PG8_BAR;
        PG8_STAGE(PG8_SB(1, 0), cB + kstep, voffB); PG8_STAGE(PG8_SA(1, 0), cA + kstep, voffA); PG8_STAGE(PG8_SB(1, 1), cB + hstep + kstep, voffB);
        PG8_WAIT_V(6); PG8_BAR;
    }
    for (;;) {
        const bool has_next = S.next(ui + 1, nxt);
        const char* nA = has_next ? (const char*)g.A + (size_t)nxt.pm * tstep : cA; const char* nB = has_next ? (const char*)g.Bt + (size_t)nxt.pn * tstep : cB;
        for (int t = 0; t < nt; t += 2) {
            const bool last = (t == nt - 2);
            const char* a1 = cA + (size_t)(t + 1) * kstep;
            const char* a2 = last ? nA : cA + (size_t)(t + 2) * kstep; const char* b2 = last ? nB : cB + (size_t)(t + 2) * kstep;
            const char* a3 = a2 + kstep; const char* b3 = b2 + kstep;
            if (last && has_next) S.a_ready(nxt);
            if constexpr (SP2) {
            PG8_LDB(B0, 0, 0); PG8_LDB(B1, 0, 1); PG8_SCHED; PG8_LDA(At, 0, 0); PG8_STAGE(PG8_SA(1, 1), a1 + hstep, voffA);
            PG8_WAIT_V(8); PG8_WAIT_L(0); PG8_BAR; PG8_MMA(0, 0, At, B0); PG8_MMA(0, 1, At, B1); PG8_BAR; PG8_SCHED;
            PG8_LDA(At, 0, 1); PG8_STAGE(PG8_SB(0, 0), b2, voffB); PG8_STAGE(PG8_SB(0, 1), b2 + hstep, voffB); PG8_STAGE(PG8_SA(0, 0), a2, voffA);
            PG8_WAIT_V(8); PG8_WAIT_L(0); PG8_BAR; PG8_MMA(1, 0, At, B0); PG8_MMA(1, 1, At, B1); PG8_BAR; PG8_SCHED;
            PG8_LDB(B0, 1, 0); PG8_LDB(B1, 1, 1); PG8_SCHED; PG8_LDA(At, 1, 0); PG8_STAGE(PG8_SA(0, 1), a2 + hstep, voffA);
            PG8_WAIT_V(8); PG8_WAIT_L(0); PG8_BAR; PG8_MMA(0, 0, At, B0); PG8_MMA(0, 1, At, B1); PG8_BAR; PG8_SCHED;
            PG8_LDA(At, 1, 1); PG8_STAGE(PG8_SB(1, 0), b3, voffB); PG8_STAGE(PG8_SB(1, 1), b3 + hstep, voffB); PG8_STAGE(PG8_SA(1, 0), a3, voffA);
            PG8_WAIT_V(8); PG8_WAIT_L(0); PG8_BAR; PG8_MMA(1, 0, At, B0); PG8_MMA(1, 1, At, B1); PG8_BAR; PG8_SCHED;
            } else {
            PG8_LDB(B0, 0, 0); PG8_SCHED; PG8_LDA(At, 0, 0); PG8_STAGE(PG8_SA(1, 1), a1 + hstep, voffA);
            PG8_WAIT_L(8); PG8_BAR; PG8_WAIT_L(0); PG8_MMA(0, 0, At, B0); PG8_BAR; PG8_SCHED;
            PG8_LDB(B1, 0, 1); PG8_STAGE(PG8_SB(0, 0), b2, voffB);
            PG8_BAR; PG8_WAIT_L(0); PG8_MMA(0, 1, At, B1); PG8_BAR;
            PG8_LDA(At, 0, 1); PG8_STAGE(PG8_SA(0, 0), a2, voffA);
            PG8_BAR; PG8_WAIT_L(0); PG8_MMA(1, 0, At, B0); PG8_BAR; PG8_SCHED;
            PG8_STAGE(PG8_SB(0, 1), b2 + hstep, voffB);
            PG8_WAIT_V(6); PG8_BAR; PG8_MMA(1, 1, At, B1); PG8_BAR;
            PG8_LDB(B0, 1, 0); PG8_SCHED; PG8_LDA(At, 1, 0); PG8_STAGE(PG8_SA(0, 1), a2 + hstep, voffA);
            PG8_WAIT_L(8); PG8_BAR; PG8_WAIT_L(0); PG8_MMA(0, 0, At, B0); PG8_BAR; PG8_SCHED;
            PG8_LDB(B1, 1, 1); PG8_STAGE(PG8_SB(1, 0), b3, voffB);
            PG8_BAR; PG8_WAIT_L(0); PG8_MMA(0, 1, At, B1); PG8_BAR;
            PG8_LDA(At, 1, 1); PG8_STAGE(PG8_SA(1, 0), a3, voffA);
            PG8_BAR; PG8_WAIT_L(0); PG8_MMA(1, 0, At, B0); PG8_BAR; PG8_SCHED;
            PG8_STAGE(PG8_SB(1, 1), b3 + hstep, voffB);
            PG8_WAIT_V(6); PG8_BAR; PG8_MMA(1, 1, At, B1); PG8_BAR;
            }
        }
        if constexpr (ALIGN_EPI) { if (wr == 0) PG8_BAR; }
        if constexpr (!Epi::AFTER_DRAIN) { E(acc, cur, wr, wc, fr, fq); S.done(cur); }
        if (!has_next) break;
#pragma unroll
        for (int a = 0; a < 2; ++a)
#pragma unroll
            for (int b = 0; b < 2; ++b)
#pragma unroll
                for (int m = 0; m < 4; ++m)
#pragma unroll
                    for (int n = 0; n < 2; ++n) acc[a][b][m][n] = (f32x4){0.f, 0.f, 0.f, 0.f};
        cur = nxt; cA = nA; cB = nB; ++ui;
        if constexpr (ALIGN_EPI) { if (wr == 1) PG8_BAR; }
    }
    PG8_WAIT_V(0);
    if constexpr (!ALIGN_EPI) { if (wr == 0) PG8_BAR; }
    PG8_BAR;
    if constexpr (Epi::AFTER_DRAIN) { E.fused(acc, cur, wr, wc, fr, fq, lds, wid, lane); S.done(cur); }
#undef PG8_SA
#undef PG8_SB
#undef PG8_STAGE
#undef PG8_LDA
#undef PG8_LDB
#undef PG8_MMA
#undef PG8_WAIT_V
#undef PG8_WAIT_L
#undef PG8_BAR
#undef PG8_SCHED
}
}

#define LAS __attribute__((address_space(3)))
typedef unsigned short bf16;
typedef pg8::f32x4 f32x4;
typedef pg8::u32x4 u32x4;
typedef pg8::bf16x8 bf16x8;
typedef unsigned u32x2 __attribute__((ext_vector_type(2)));
typedef float f32x2v __attribute__((ext_vector_type(2)));

constexpr int NB = 4, SEQ = 8192, D = 1024, M = NB * SEQ;
constexpr int NH = 4, DK = 256, DV = 512;
constexpr int NT1 = 24, NT2 = 20, NIN = (NT1 + NT2) * 256;
constexpr int NPHASE = 9;

constexpr size_t MiB = 1u << 20;
constexpr size_t WS_CTL = 0, CTL_BYTES = 1 * MiB;
constexpr size_t WS_MOD = 1 * MiB;
constexpr size_t WS_WIN = 2 * MiB;
constexpr size_t WS_WRET = 24 * MiB;
constexpr size_t WS_WCONV = 28 * MiB;
constexpr size_t WS_WOUT = 30 * MiB;
constexpr size_t WS_H = 32 * MiB;
constexpr size_t WS_Q = 96 * MiB;
constexpr size_t WS_K = 160 * MiB;
constexpr size_t WS_V = 224 * MiB;
constexpr size_t WS_ZR = 352 * MiB;
constexpr size_t WS_END = 480 * MiB;
constexpr int CW_BAR = 4096;

typedef float f32x2_t __attribute__((ext_vector_type(2)));
typedef __bf16 bf16x2_t __attribute__((ext_vector_type(2)));
__device__ __forceinline__ unsigned cvt_pk(float lo, float hi) { const f32x2_t v = {lo, hi}; const bf16x2_t b = __builtin_convertvector(v, bf16x2_t); return __builtin_bit_cast(unsigned, b); }
__device__ __forceinline__ float bf_lo(unsigned u) { return __uint_as_float(u << 16); }
__device__ __forceinline__ float bf_hi(unsigned u) { return __uint_as_float(u & 0xffff0000u); }
__device__ __forceinline__ float fsigmoid(float x) { return __builtin_amdgcn_rcpf(1.0f + __builtin_amdgcn_exp2f(x * -1.4426950408889634f)); }
__device__ __forceinline__ float fsilu(float x) { return x * fsigmoid(x); }

struct EpiProj1 {
    static constexpr bool PERM = true, AFTER_DRAIN = false;
    bf16* Q; bf16* K; bf16* V; bf16* ZR; const int* pos;
    __device__ __forceinline__ void operator()(const f32x4 (&acc)[2][2][4][2], const pg8::Unit& u, int wr, int wc, int fr, int fq) const {
        const int row0 = u.pm * 256 + wr * 64 + fr, cb = wc * 32 + 8 * fq, pn = u.pn;
        if (pn < 8) {
            bf16* base = (pn < 4 ? Q : K) + (pn & 3) * 256 + cb;
            const float sc = pn < 4 ? 1.0f : 0.0625f;
            float invf[8];
#pragma unroll
            for (int i = 0; i < 8; ++i) invf[i] = exp2f((float)(cb + i) * (-13.287712379549449f / 128.0f));
#pragma unroll
            for (int ai = 0; ai < 2; ++ai)
#pragma unroll
                for (int m = 0; m < 4; ++m) {
                    const int row = row0 + ai * 128 + m * 16;
                    const float p = (float)pos[row];
                    float o1[8], o2[8];
#pragma unroll
                    for (int n = 0; n < 2; ++n)
#pragma unroll
                        for (int j = 0; j < 4; ++j) {
                            const float ang = p * invf[n * 4 + j];
                            const float nn = rintf(ang * 0.15915494309189535f);
                            float r = fmaf(-nn, 6.2831854820251465f, ang);
                            r = fmaf(-nn, -1.7484555e-7f, r);
                            const float rv = r * 0.15915494309189535f;
                            const float s = __builtin_amdgcn_sinf(rv), c = __builtin_amdgcn_cosf(rv);
                            const float t1 = acc[ai][0][m][n][j], t2 = acc[ai][1][m][n][j];
                            o1[n * 4 + j] = (t1 * c - t2 * s) * sc; o2[n * 4 + j] = (t1 * s + t2 * c) * sc;
                        }
                    bf16* rp = base + (size_t)row * 1024;
                    u32x4 w1, w2;
                    w1.x = cvt_pk(o1[0], o1[1]); w1.y = cvt_pk(o1[2], o1[3]); w1.z = cvt_pk(o1[4], o1[5]); w1.w = cvt_pk(o1[6], o1[7]);
                    w2.x = cvt_pk(o2[0], o2[1]); w2.y = cvt_pk(o2[2], o2[3]); w2.z = cvt_pk(o2[4], o2[5]); w2.w = cvt_pk(o2[6], o2[7]);
                    *(u32x4*)rp = w1; *(u32x4*)(rp + 128) = w2;
                }
        } else {
            const bool act = pn >= 16;
            bf16* base = (act ? ZR + (pn - 16) * 256 : V + (pn - 8) * 256) + cb;
#pragma unroll
            for (int ai = 0; ai < 2; ++ai)
#pragma unroll
                for (int m = 0; m < 4; ++m) {
                    bf16* rp = base + (size_t)(row0 + ai * 128 + m * 16) * 2048;
#pragma unroll
                    for (int bj = 0; bj < 2; ++bj) {
                        f32x4 v0 = acc[ai][bj][m][0], v1 = acc[ai][bj][m][1];
                        if (act) {
#pragma unroll
                            for (int j = 0; j < 4; ++j) { v0[j] = fsilu(v0[j]); v1[j] = fsilu(v1[j]); }
                        }
                        u32x4 w; w.x = cvt_pk(v0[0], v0[1]); w.y = cvt_pk(v0[2], v0[3]); w.z = cvt_pk(v1[0], v1[1]); w.w = cvt_pk(v1[2], v1[3]);
                        *(u32x4*)(rp + bj * 128) = w;
                    }
                }
        }
    }
};
struct EpiProj2 {
    static constexpr bool PERM = true, AFTER_DRAIN = false;
    bf16* A; bf16* ZC; bf16* SGA; bf16* SGB;
    __device__ __forceinline__ void operator()(const f32x4 (&acc)[2][2][4][2], const pg8::Unit& u, int wr, int wc, int fr, int fq) const {
        const int row0 = u.pm * 256 + wr * 64 + fr, cb = wc * 32 + 8 * fq, pn = u.pn;
        if (pn < 8) {
            bf16* base = A + pn * 128 + cb;
#pragma unroll
            for (int ai = 0; ai < 2; ++ai)
#pragma unroll
                for (int m = 0; m < 4; ++m) {
                    f32x4 v0 = acc[ai][0][m][0], v1 = acc[ai][0][m][1]; const f32x4 g0 = acc[ai][1][m][0], g1 = acc[ai][1][m][1];
#pragma unroll
                    for (int j = 0; j < 4; ++j) { v0[j] *= fsigmoid(g0[j]); v1[j] *= fsigmoid(g1[j]); }
                    u32x4 w; w.x = cvt_pk(v0[0], v0[1]); w.y = cvt_pk(v0[2], v0[3]); w.z = cvt_pk(v1[0], v1[1]); w.w = cvt_pk(v1[2], v1[3]);
                    *(u32x4*)(base + (size_t)(row0 + ai * 128 + m * 16) * 1024) = w;
                }
        } else {
            const bool isz = pn < 12;
            bf16* base = (isz ? ZC + (pn - 8) * 256 : (pn < 16 ? SGA + (pn - 12) * 256 : SGB + (pn - 16) * 256)) + cb;
#pragma unroll
            for (int ai = 0; ai < 2; ++ai)
#pragma unroll
                for (int m = 0; m < 4; ++m) {
                    bf16* rp = base + (size_t)(row0 + ai * 128 + m * 16) * 1024;
#pragma unroll
                    for (int bj = 0; bj < 2; ++bj) {
                        f32x4 v0 = acc[ai][bj][m][0], v1 = acc[ai][bj][m][1];
#pragma unroll
                        for (int j = 0; j < 4; ++j) { const float s0 = fsigmoid(v0[j]), s1 = fsigmoid(v1[j]); v0[j] = isz ? v0[j] * s0 : s0; v1[j] = isz ? v1[j] * s1 : s1; }
                        u32x4 w; w.x = cvt_pk(v0[0], v0[1]); w.y = cvt_pk(v0[2], v0[3]); w.z = cvt_pk(v1[0], v1[1]); w.w = cvt_pk(v1[2], v1[3]);
                        *(u32x4*)(rp + bj * 128) = w;
                    }
                }
        }
    }
};
struct EpiYa {
    static constexpr bool PERM = true, AFTER_DRAIN = false;
    float* TA; const bf16* SGA;
    __device__ __forceinline__ void operator()(const f32x4 (&acc)[2][2][4][2], const pg8::Unit& u, int wr, int wc, int fr, int fq) const {
        const int row0 = u.pm * 256 + wr * 64 + fr, col0 = u.pn * 256 + wc * 32 + 8 * fq;
#pragma unroll
        for (int ai = 0; ai < 2; ++ai)
#pragma unroll
            for (int m = 0; m < 4; ++m) {
                const size_t ro = (size_t)(row0 + ai * 128 + m * 16) * 1024 + col0;
#pragma unroll
                for (int bj = 0; bj < 2; ++bj) {
                    const u32x4 g = *(const u32x4*)(SGA + ro + bj * 128);
                    f32x4 v0 = acc[ai][bj][m][0], v1 = acc[ai][bj][m][1];
                    v0[0] *= bf_lo(g.x); v0[1] *= bf_hi(g.x); v0[2] *= bf_lo(g.y); v0[3] *= bf_hi(g.y);
                    v1[0] *= bf_lo(g.z); v1[1] *= bf_hi(g.z); v1[2] *= bf_lo(g.w); v1[3] *= bf_hi(g.w);
                    *(f32x4*)(TA + ro + bj * 128) = v0; *(f32x4*)(TA + ro + bj * 128 + 4) = v1;
                }
            }
    }
};
struct EpiYb {
    static constexpr bool PERM = true, AFTER_DRAIN = false;
    const float* TA; const bf16* SGB; bf16* MG;
    __device__ __forceinline__ void operator()(const f32x4 (&acc)[2][2][4][2], const pg8::Unit& u, int wr, int wc, int fr, int fq) const {
        const int row0 = u.pm * 256 + wr * 64 + fr, col0 = u.pn * 256 + wc * 32 + 8 * fq;
#pragma unroll
        for (int ai = 0; ai < 2; ++ai)
#pragma unroll
            for (int m = 0; m < 4; ++m) {
                const size_t ro = (size_t)(row0 + ai * 128 + m * 16) * 1024 + col0;
#pragma unroll
                for (int bj = 0; bj < 2; ++bj) {
                    const u32x4 g = *(const u32x4*)(SGB + ro + bj * 128);
                    const f32x4 t0 = *(const f32x4*)(TA + ro + bj * 128), t1 = *(const f32x4*)(TA + ro + bj * 128 + 4);
                    f32x4 v0 = acc[ai][bj][m][0], v1 = acc[ai][bj][m][1];
                    v0[0] = t0[0] + v0[0] * bf_lo(g.x); v0[1] = t0[1] + v0[1] * bf_hi(g.x); v0[2] = t0[2] + v0[2] * bf_lo(g.y); v0[3] = t0[3] + v0[3] * bf_hi(g.y);
                    v1[0] = t1[0] + v1[0] * bf_lo(g.z); v1[1] = t1[1] + v1[1] * bf_hi(g.z); v1[2] = t1[2] + v1[2] * bf_lo(g.w); v1[3] = t1[3] + v1[3] * bf_hi(g.w);
                    u32x4 w; w.x = cvt_pk(v0[0], v0[1]); w.y = cvt_pk(v0[2], v0[3]); w.z = cvt_pk(v1[0], v1[1]); w.w = cvt_pk(v1[2], v1[3]);
                    *(u32x4*)(MG + ro + bj * 128) = w;
                }
            }
    }
};
struct EpiY {
    static constexpr bool PERM = true, AFTER_DRAIN = false;
    float* Y;
    __device__ __forceinline__ void operator()(const f32x4 (&acc)[2][2][4][2], const pg8::Unit& u, int wr, int wc, int fr, int fq) const {
        const int row0 = u.pm * 256 + wr * 64 + fr, col0 = u.pn * 256 + wc * 32 + 8 * fq;
#pragma unroll
        for (int ai = 0; ai < 2; ++ai)
#pragma unroll
            for (int m = 0; m < 4; ++m) {
                float* rp = Y + (size_t)(row0 + ai * 128 + m * 16) * 1024 + col0;
#pragma unroll
                for (int bj = 0; bj < 2; ++bj) { *(f32x4*)(rp + bj * 128) = acc[ai][bj][m][0]; *(f32x4*)(rp + bj * 128 + 4) = acc[ai][bj][m][1]; }
            }
    }
};
#define XB_TMO      128
#define XB_XCNT(j)  (256  + 64 * (j))
#define XB_XSUB(j)  (1280 + 64 * (j))
#define XB_XGEN(j)  (2304 + 64 * (j))
#define XB_TOP      3328
#define XB_TOPGEN   3392
#define XCD_BAR_WORDS 3456
#define XB_SPIN_CAP (1u << 18)

__device__ __forceinline__ unsigned xb_ld(unsigned* p)              { return __hip_atomic_load(p, __ATOMIC_RELAXED, __HIP_MEMORY_SCOPE_AGENT); }
__device__ __forceinline__ unsigned xb_add(unsigned* p, unsigned v) { return __hip_atomic_fetch_add(p, v, __ATOMIC_RELAXED, __HIP_MEMORY_SCOPE_AGENT); }
__device__ __forceinline__ unsigned xb_xcc_id() { return (unsigned)__builtin_amdgcn_s_getreg((3 << 11) | 20) & 0xFu; }
#define XB_SPIN(cond, bar) do { unsigned _sp = 0; while (cond) { __builtin_amdgcn_s_sleep(1); \
    if ((++_sp & 255u) == 0u) { if (xb_ld(&(bar)[XB_TMO])) break; if (_sp > XB_SPIN_CAP) { atomicAdd(&(bar)[XB_TMO], 1u); break; } } } } while (0)

struct XcdBarrier {
    unsigned* bar; unsigned x;
    volatile LAS unsigned* st;
};

__device__ __forceinline__ XcdBarrier xcd_barrier_post(unsigned* bar, volatile LAS unsigned* st) {
    XcdBarrier b; b.bar = bar; b.x = xb_xcc_id(); b.st = st;
    if (threadIdx.x == 0) (void)xb_add(&bar[XB_XCNT(b.x)], 1u);
    return b;
}
__device__ __forceinline__ void xcd_barrier_complete(unsigned* bar, unsigned x, unsigned& nloc, unsigned& nx) {
    const unsigned G = gridDim.x * gridDim.y * gridDim.z;
    unsigned sum, cnt, mine, sp = 0u;
    for (;;) {
        sum = 0u; cnt = 0u; mine = 0u;
#pragma unroll
        for (unsigned j = 0; j < 16; ++j) { const unsigned c = xb_ld(&bar[XB_XCNT(j)]); sum += c; cnt += (c > 0u) ? 1u : 0u; mine = (j == x) ? c : mine; }
        if (sum == G) break;
        __builtin_amdgcn_s_sleep(1);
        if ((++sp & 255u) == 0u) { if (xb_ld(&bar[XB_TMO])) break; if (sp > XB_SPIN_CAP) { atomicAdd(&bar[XB_TMO], 1u); break; } }
    }
    nloc = mine > 0u ? mine : 1u; nx = cnt > 0u ? cnt : 1u;
}

__device__ __forceinline__ void xcd_barrier(const XcdBarrier& b) {
    asm volatile("s_waitcnt vmcnt(0)" ::: "memory");
    __syncthreads();
    if (threadIdx.x == 0) {
        unsigned* bar = b.bar;
        __builtin_amdgcn_s_waitcnt(0);
        unsigned nloc = b.st[0], nx = b.st[1];
        if (nloc == 0u) { xcd_barrier_complete(bar, b.x, nloc, nx); b.st[0] = nloc; b.st[1] = nx; }
        const unsigned old = xb_add(&bar[XB_XSUB(b.x)], 1u);
        const unsigned gen = old / nloc;
        if (old + 1u == (gen + 1u) * nloc) {
            __builtin_amdgcn_fence(__ATOMIC_RELEASE, "agent");
            asm volatile("s_waitcnt vmcnt(0)" ::: "memory");
            const unsigned og = xb_add(&bar[XB_TOP], 1u);
            const unsigned tg = og / nx;
            if (og + 1u == (tg + 1u) * nx) xb_add(&bar[XB_TOPGEN], 1u);
            else XB_SPIN(xb_ld(&bar[XB_TOPGEN]) == tg, bar);
            __builtin_amdgcn_fence(__ATOMIC_ACQUIRE, "agent");
            xb_add(&bar[XB_XGEN(b.x)], 1u);
            asm volatile("s_waitcnt vmcnt(0)" ::: "memory");
        } else {
            XB_SPIN(xb_ld(&bar[XB_XGEN(b.x)]) == gen, bar);
            __builtin_amdgcn_fence(__ATOMIC_ACQUIRE, "agent");
            asm volatile("s_waitcnt vmcnt(0)" ::: "memory");
        }
    }
    __syncthreads();
}

constexpr int RING_BYTES = 131072;
constexpr int LDSCTL_OFF = RING_BYTES, MISC_OFF = LDSCTL_OFF + 320;
constexpr int LDS_BYTES = 147456;
struct Frame {
    LAS unsigned char* lds;
    volatile LAS unsigned* MISC;
    unsigned* ctl;
    int tid, lane, wave, vcu, G;
    const float *x, *c, *w_ada, *b_ada, *pre_g, *w_in, *conv_w, *conv_b, *ln_g, *ln_b, *w_ret, *w_conv, *w_out, *post_g;
    const int* pos;
    float* out; float* mod;
    bf16 *WIN, *WRET, *WCONV, *WOUT, *H, *Q, *K, *V, *ZR, *SGA, *SGB;
    float* F32S;
};
__device__ __forceinline__ float wave_sum(float v) {
#pragma unroll
    for (int o = 1; o < 64; o <<= 1) v += __shfl_xor(v, o);
    return v;
}
#define LDS_WAIT() asm volatile("s_waitcnt lgkmcnt(0)" ::: "memory")

__device__ __forceinline__ void transpose_item(const float* W, int K, int N, bf16* WT, int dst_row0, int src_col0, int k0, LAS float* scr, int lane) {
#pragma unroll 8
    for (int i = 0; i < 32; ++i) { const int kk = 2 * i + (lane >> 5); scr[kk * 33 + (lane & 31)] = W[(size_t)(k0 + kk) * N + src_col0 + (lane & 31)]; }
    LDS_WAIT(); asm volatile("" ::: "memory");
    const int c = lane & 7;
#pragma unroll
    for (int j = 0; j < 4; ++j) { const int n = (lane >> 3) + 8 * j; const LAS float* s = scr + (8 * c) * 33 + n;
        u32x4 o; o.x = cvt_pk(s[0 * 33], s[1 * 33]); o.y = cvt_pk(s[2 * 33], s[3 * 33]); o.z = cvt_pk(s[4 * 33], s[5 * 33]); o.w = cvt_pk(s[6 * 33], s[7 * 33]);
        *(u32x4*)(WT + (size_t)(dst_row0 + n) * K + k0 + 8 * c) = o; }
    LDS_WAIT(); asm volatile("" ::: "memory");
}
__device__ __forceinline__ int win_src_col(int n0) {
    if (n0 >= 6144 && n0 < 8192) { const int t = (n0 - 6144) >> 8, wi = (n0 - 6144) & 255; return wi < 128 ? 6144 + 128 * t + wi : 7168 + 128 * t + (wi - 128); }
    return n0;
}
__device__ __forceinline__ void phase0(Frame& F) {
    LAS float* red = (LAS float*)F.lds;
    for (int cg = blockIdx.x; cg < 48; cg += F.G) {
        const int col = cg * 64 + F.lane; float a0 = 0.f, a1 = 0.f, a2 = 0.f, a3 = 0.f;
        const int kb = F.wave * 128;
#pragma unroll 16
        for (int k = 0; k < 128; ++k) { const float wv = F.w_ada[(size_t)(kb + k) * 3072 + col];
            a0 = fmaf(F.c[kb + k], wv, a0); a1 = fmaf(F.c[1024 + kb + k], wv, a1); a2 = fmaf(F.c[2048 + kb + k], wv, a2); a3 = fmaf(F.c[3072 + kb + k], wv, a3); }
        red[(F.wave * 4 + 0) * 64 + F.lane] = a0; red[(F.wave * 4 + 1) * 64 + F.lane] = a1; red[(F.wave * 4 + 2) * 64 + F.lane] = a2; red[(F.wave * 4 + 3) * 64 + F.lane] = a3;
        __syncthreads();
        if (F.wave < 4) { float s = 0.f;
#pragma unroll
            for (int w = 0; w < 8; ++w) s += red[(w * 4 + F.wave) * 64 + F.lane];
            F.mod[F.wave * 3072 + col] = s + F.b_ada[col]; }
        __syncthreads();
    }
    LAS float* scr = (LAS float*)(F.lds + F.wave * 8448);
    const int gw = F.vcu * 8 + F.wave, NGW = F.G * 8;
    constexpr int I_IN = 16 * 352, I_RET = 32 * 32, I_CV = 16 * 32, I_OUT = 16 * 32;
    for (int it = gw; it < I_IN + I_RET + I_CV + I_OUT; it += NGW) {
        int r = it;
        if (r < I_IN) { const int kb = r / 352, nb = r % 352; transpose_item(F.w_in, 1024, NIN, F.WIN, nb * 32, win_src_col(nb * 32), kb * 64, scr, F.lane); continue; } r -= I_IN;
        if (r < I_RET) { const int kb = r >> 5, nb = r & 31; transpose_item(F.w_ret, 2048, 1024, F.WRET, nb * 32, nb * 32, kb * 64, scr, F.lane); continue; } r -= I_RET;
        if (r < I_CV) { const int kb = r >> 5, nb = r & 31; transpose_item(F.w_conv, 1024, 1024, F.WCONV, nb * 32, nb * 32, kb * 64, scr, F.lane); continue; } r -= I_CV;
        { const int kb = r >> 5, nb = r & 31; transpose_item(F.w_out, 1024, 1024, F.WOUT, nb * 32, nb * 32, kb * 64, scr, F.lane); }
    }
}
__device__ __forceinline__ void phase1(Frame& F) {
    const int gw = F.vcu * 8 + F.wave, NGW = F.G * 8;
    for (int rb = gw; rb < M / 16; rb += NGW) {
        const int b = (rb * 16) / SEQ;
        f32x4 ca[4], cs[4];
#pragma unroll
        for (int j = 0; j < 4; ++j) { const int col = 4 * F.lane + 256 * j;
            const f32x4 g = *(const f32x4*)(F.pre_g + col), sc = *(const f32x4*)(F.mod + b * 3072 + 1024 + col);
            ca[j] = g * (sc + 1.0f); cs[j] = *(const f32x4*)(F.mod + b * 3072 + col); }
        for (int r = 0; r < 16; ++r) {
            const size_t m = (size_t)rb * 16 + r;
            const f32x4* xr = (const f32x4*)(F.x + m * D) + F.lane;
            f32x4 v[4]; float ss = 0.f;
#pragma unroll
            for (int j = 0; j < 4; ++j) { v[j] = xr[64 * j]; ss += (v[j][0] * v[j][0] + v[j][1] * v[j][1]) + (v[j][2] * v[j][2] + v[j][3] * v[j][3]); }
            const float rstd = rsqrtf(wave_sum(ss) * (1.0f / D) + 1e-6f);
            u32x2* o8 = (u32x2*)(F.H + m * D) + F.lane;
#pragma unroll
            for (int j = 0; j < 4; ++j) { const f32x4 y = v[j] * rstd * ca[j] + cs[j]; u32x2 w; w.x = cvt_pk(y[0], y[1]); w.y = cvt_pk(y[2], y[3]); o8[64 * j] = w; }
        }
    }
}
constexpr int RT_ROW = 544, RT_PROW = 160;
constexpr int RT_QS = 0, RT_KS = 64 * RT_ROW, RT_P = 2 * 64 * RT_ROW, RT_VT = RT_P + 64 * RT_PROW, RT_ST = RT_VT + 32 * RT_PROW, RT_STB = 32 * RT_ROW;
static_assert(RT_ST + 2 * RT_STB <= RING_BYTES, "retention LDS map");
typedef short v4i16_t __attribute__((ext_vector_type(4)));
__device__ __forceinline__ bf16x8 ldfrag(const LAS unsigned char* p) { return *(const LAS bf16x8*)p; }
__device__ __forceinline__ v4i16_t ldtr(const LAS unsigned char* p) { return __builtin_amdgcn_ds_read_tr16_b64_v4i16((LAS v4i16_t*)p); }
#define MFMA16(a, b, c) __builtin_amdgcn_mfma_f32_16x16x32_bf16(a, b, c, 0, 0, 0)
__device__ __forceinline__ void phase3(Frame& F) {
    LAS unsigned char* lds = F.lds;
    const int tid = F.tid, lane = F.lane, w = F.wave, fr = lane & 15, fq = lane >> 4;
    const int srow = tid >> 5, sc16 = tid & 31, vrow = tid >> 3, ve4 = (tid & 7) * 4;
    const int ib = w >> 1, eb = w & 1, il = ib * 16 + fr, jb0 = (w & 1) * 2;
    for (int item = F.vcu; item < 256; item += F.G) {
        const int bh = item >> 4, sl = item & 15, b = bh >> 2, h = bh & 3;
        const float l2g = log2f(1.0f - exp2f(-5.0f - (float)h));
        const bf16* Qg = F.Q + (size_t)b * SEQ * 1024 + h * 256;
        const bf16* Kg = F.K + (size_t)b * SEQ * 1024 + h * 256;
        bf16* Vg = F.V + (size_t)b * SEQ * 2048 + h * 512 + sl * 32;
        const float zeta = exp2f((float)(63 - vrow) * l2g);
        const float rs1 = exp2f((float)(il - 63) * l2g), xi = exp2f((float)(il + 1) * l2g), gC = exp2f(64.0f * l2g);
        f32x4 st[2][2];
#pragma unroll
        for (int a = 0; a < 2; ++a)
#pragma unroll
            for (int e = 0; e < 2; ++e) st[a][e] = (f32x4){0.f, 0.f, 0.f, 0.f};
        for (int i = tid; i < RT_STB / 16; i += 512) *(LAS u32x4*)(lds + RT_ST + i * 16) = (u32x4){0u, 0u, 0u, 0u};
        u32x4 pq[4], pk[4]; u32x2 pv;
#pragma unroll
        for (int i = 0; i < 4; ++i) { pq[i] = *(const u32x4*)(Qg + (size_t)(srow + 16 * i) * 1024 + sc16 * 8); pk[i] = *(const u32x4*)(Kg + (size_t)(srow + 16 * i) * 1024 + sc16 * 8); }
        pv = *(const u32x2*)(Vg + (size_t)vrow * 2048 + ve4);
        for (int n = 0; n < SEQ / 64; ++n) {
            const int cur = n & 1, nxt = cur ^ 1;
#pragma unroll
            for (int i = 0; i < 4; ++i) { *(LAS u32x4*)(lds + RT_QS + (srow + 16 * i) * RT_ROW + sc16 * 16) = pq[i]; *(LAS u32x4*)(lds + RT_KS + (srow + 16 * i) * RT_ROW + sc16 * 16) = pk[i]; }
            { const unsigned z01 = cvt_pk(bf_lo(pv.x) * zeta, bf_hi(pv.x) * zeta), z23 = cvt_pk(bf_lo(pv.y) * zeta, bf_hi(pv.y) * zeta);
              LAS unsigned short* vt = (LAS unsigned short*)(lds + RT_VT + ve4 * RT_PROW + vrow * 2);
              vt[0] = (unsigned short)(z01 & 0xffffu); vt[RT_PROW / 2] = (unsigned short)(z01 >> 16); vt[RT_PROW] = (unsigned short)(z23 & 0xffffu); vt[3 * RT_PROW / 2] = (unsigned short)(z23 >> 16); }
            __syncthreads();
            if (n + 1 < SEQ / 64) {
                const size_t r0 = (size_t)(n + 1) * 64;
#pragma unroll
                for (int i = 0; i < 4; ++i) { pq[i] = *(const u32x4*)(Qg + (r0 + srow + 16 * i) * 1024 + sc16 * 8); pk[i] = *(const u32x4*)(Kg + (r0 + srow + 16 * i) * 1024 + sc16 * 8); }
                pv = *(const u32x2*)(Vg + (r0 + vrow) * 2048 + ve4);
            }
            const LAS unsigned char* qrow = lds + RT_QS + il * RT_ROW + fq * 16;
            {
                f32x4 s0 = (f32x4){0.f, 0.f, 0.f, 0.f}, s1 = (f32x4){0.f, 0.f, 0.f, 0.f};
                const LAS unsigned char* krow = lds + RT_KS + (jb0 * 16 + fr) * RT_ROW + fq * 16;
#pragma unroll
                for (int ks = 0; ks < 8; ++ks) { const bf16x8 qf = ldfrag(qrow + ks * 64), k0 = ldfrag(krow + ks * 64), k1 = ldfrag(krow + 16 * RT_ROW + ks * 64);
                    s0 = MFMA16(k0, qf, s0); s1 = MFMA16(k1, qf, s1); }
                const int j0 = jb0 * 16 + 4 * fq;
#pragma unroll
                for (int x = 0; x < 4; ++x) { if (j0 + x > il) s0[x] = 0.f; if (j0 + 16 + x > il) s1[x] = 0.f; }
                u32x2 p0, p1; p0.x = cvt_pk(s0[0], s0[1]); p0.y = cvt_pk(s0[2], s0[3]); p1.x = cvt_pk(s1[0], s1[1]); p1.y = cvt_pk(s1[2], s1[3]);
                *(LAS u32x2*)(lds + RT_P + il * RT_PROW + j0 * 2) = p0; *(LAS u32x2*)(lds + RT_P + il * RT_PROW + (j0 + 16) * 2) = p1;
            }
            __syncthreads();
            {
                f32x4 aP = (f32x4){0.f, 0.f, 0.f, 0.f}, aQ = (f32x4){0.f, 0.f, 0.f, 0.f};
                const LAS unsigned char* vtrow = lds + RT_VT + (eb * 16 + fr) * RT_PROW + fq * 16;
                const LAS unsigned char* prow = lds + RT_P + il * RT_PROW + fq * 16;
#pragma unroll
                for (int ks = 0; ks < 2; ++ks) aP = MFMA16(ldfrag(vtrow + ks * 64), ldfrag(prow + ks * 64), aP);
                const LAS unsigned char* strow = lds + RT_ST + cur * RT_STB + (eb * 16 + fr) * RT_ROW + fq * 16;
#pragma unroll
                for (int ks = 0; ks < 8; ++ks) aQ = MFMA16(ldfrag(strow + ks * 64), ldfrag(qrow + ks * 64), aQ);
                u32x2 o; o.x = cvt_pk(rs1 * aP[0] + xi * aQ[0], rs1 * aP[1] + xi * aQ[1]); o.y = cvt_pk(rs1 * aP[2] + xi * aQ[2], rs1 * aP[3] + xi * aQ[3]);
                *(u32x2*)(Vg + ((size_t)n * 64 + il) * 2048 + eb * 16 + 4 * fq) = o;
            }
            {
#pragma unroll
                for (int a = 0; a < 2; ++a)
#pragma unroll
                    for (int e = 0; e < 2; ++e) st[a][e] = st[a][e] * gC;
                const int q4 = fr >> 2, p4 = fr & 3;
#pragma unroll
                for (int ks = 0; ks < 2; ++ks) {
                    bf16x8 vf[2];
#pragma unroll
                    for (int e = 0; e < 2; ++e) vf[e] = ldfrag(lds + RT_VT + (e * 16 + fr) * RT_PROW + fq * 16 + ks * 64);
#pragma unroll
                    for (int a = 0; a < 2; ++a) {
                        const LAS unsigned char* kp = lds + RT_KS + (32 * ks + 8 * fq + q4) * RT_ROW + 32 * (2 * w + a) + 8 * p4;
                        const v4i16_t t0 = ldtr(kp), t1 = ldtr(kp + 4 * RT_ROW);
                        bf16x8 kf; kf[0] = t0[0]; kf[1] = t0[1]; kf[2] = t0[2]; kf[3] = t0[3]; kf[4] = t1[0]; kf[5] = t1[1]; kf[6] = t1[2]; kf[7] = t1[3];
#pragma unroll
                        for (int e = 0; e < 2; ++e) st[a][e] = MFMA16(kf, vf[e], st[a][e]);
                    }
                }
#pragma unroll
                for (int a = 0; a < 2; ++a)
#pragma unroll
                    for (int e = 0; e < 2; ++e) { u32x2 sv; sv.x = cvt_pk(st[a][e][0], st[a][e][1]); sv.y = cvt_pk(st[a][e][2], st[a][e][3]);
                        *(LAS u32x2*)(lds + RT_ST + nxt * RT_STB + (e * 16 + fr) * RT_ROW + (16 * (2 * w + a) + 4 * fq) * 2) = sv; }
            }
            __syncthreads();
        }
    }
}
__device__ __forceinline__ void gn_pass(Frame& F) {
    const int gw = F.vcu * 8 + F.wave, NGW = F.G * 8;
    for (int p = gw; p < M * NH; p += NGW) {
        const size_t off = (size_t)(p >> 2) * 2048 + (p & 3) * 512 + F.lane * 8;
        const u32x4 o = *(const u32x4*)(F.V + off), z = *(const u32x4*)(F.ZR + off);
        float v[8] = {bf_lo(o.x), bf_hi(o.x), bf_lo(o.y), bf_hi(o.y), bf_lo(o.z), bf_hi(o.z), bf_lo(o.w), bf_hi(o.w)};
        const float zf[8] = {bf_lo(z.x), bf_hi(z.x), bf_lo(z.y), bf_hi(z.y), bf_lo(z.z), bf_hi(z.z), bf_lo(z.w), bf_hi(z.w)};
        float s = 0.f;
#pragma unroll
        for (int i = 0; i < 8; ++i) s += v[i];
        const float mean = wave_sum(s) * (1.0f / 512.0f); float q = 0.f;
#pragma unroll
        for (int i = 0; i < 8; ++i) { v[i] -= mean; q += v[i] * v[i]; }
        const float rstd = rsqrtf(wave_sum(q) * (1.0f / 512.0f) + 1e-5f);
        u32x4 r; r.x = cvt_pk(v[0] * rstd * zf[0], v[1] * rstd * zf[1]); r.y = cvt_pk(v[2] * rstd * zf[2], v[3] * rstd * zf[3]);
        r.z = cvt_pk(v[4] * rstd * zf[4], v[5] * rstd * zf[5]); r.w = cvt_pk(v[6] * rstd * zf[6], v[7] * rstd * zf[7]);
        *(u32x4*)(F.ZR + off) = r;
    }
}
__device__ __forceinline__ void conv_pass(Frame& F) {
    LAS float* red = (LAS float*)F.lds;
    const int t = F.tid, c0 = 2 * t;
    float w0[31], w1[31];
#pragma unroll
    for (int k = 0; k < 31; ++k) { const f32x2v wv = *(const f32x2v*)(F.conv_w + k * 1024 + c0); w0[k] = wv.x; w1[k] = wv.y; }
    const f32x2v cb = *(const f32x2v*)(F.conv_b + c0), lg = *(const f32x2v*)(F.ln_g + c0), lb = *(const f32x2v*)(F.ln_b + c0);
    const bf16* A = F.Q;
    bf16* ZC = F.K;
    for (int tile = F.vcu; tile < M / 128; tile += F.G) {
        const int tok0 = tile * 128, b = tok0 / SEQ, s0 = tok0 % SEQ;
        const bf16* Ab = A + (size_t)b * SEQ * 1024 + c0;
        for (int gi = 0; gi < 16; ++gi) {
            const int sf = s0 + 8 * gi;
            float in0[38], in1[38];
#pragma unroll
            for (int i = 0; i < 38; ++i) { const int s = sf - 30 + i; const int sc = s < 0 ? 0 : s;
                unsigned uu = *(const unsigned*)(Ab + (size_t)sc * 1024); if (s < 0) uu = 0u; in0[i] = bf_lo(uu); in1[i] = bf_hi(uu); }
            float a0[8], a1[8], ps[16];
#pragma unroll
            for (int j = 0; j < 8; ++j) { float x0 = cb.x, x1 = cb.y;
#pragma unroll
                for (int k = 0; k < 31; ++k) { x0 = fmaf(w0[k], in0[j + k], x0); x1 = fmaf(w1[k], in1[j + k], x1); }
                a0[j] = x0; a1[j] = x1; ps[j] = x0 + x1; ps[8 + j] = x0 * x0 + x1 * x1; }
#pragma unroll
            for (int j = 0; j < 16; ++j) ps[j] = wave_sum(ps[j]);
            if (F.lane < 16) { float v = ps[0];
#pragma unroll
                for (int j = 1; j < 16; ++j) v = (F.lane == j) ? ps[j] : v;
                red[F.wave * 16 + F.lane] = v; }
            __syncthreads();
            if (t < 16) { float s = 0.f;
#pragma unroll
                for (int w = 0; w < 8; ++w) s += red[w * 16 + t];
                red[128 + t] = s; }
            __syncthreads();
#pragma unroll
            for (int j = 0; j < 8; ++j) {
                const float mean = red[128 + j] * (1.0f / 1024.0f), var = red[136 + j] * (1.0f / 1024.0f) - mean * mean, rstd = rsqrtf(var + 1e-5f);
                const float y0 = (a0[j] - mean) * rstd * lg.x + lb.x, y1 = (a1[j] - mean) * rstd * lg.y + lb.y;
                unsigned* zp = (unsigned*)(ZC + (size_t)(tok0 + 8 * gi + j) * 1024 + c0);
                const unsigned zz = *zp;
                *zp = cvt_pk(fsilu(y0) * bf_lo(zz), fsilu(y1) * bf_hi(zz));
            }
        }
    }
    __syncthreads();
}
__device__ __forceinline__ void phase8(Frame& F) {
    const int gw = F.vcu * 8 + F.wave, NGW = F.G * 8;
    for (int rb = gw; rb < M / 16; rb += NGW) {
        const int b = (rb * 16) / SEQ;
        f32x4 cg[4];
#pragma unroll
        for (int j = 0; j < 4; ++j) { const int col = 4 * F.lane + 256 * j; cg[j] = *(const f32x4*)(F.post_g + col) * *(const f32x4*)(F.mod + b * 3072 + 2048 + col); }
        for (int r = 0; r < 16; ++r) {
            const size_t m = (size_t)rb * 16 + r;
            const f32x4* yr = (const f32x4*)(F.F32S + m * D) + F.lane; const f32x4* xr = (const f32x4*)(F.x + m * D) + F.lane;
            f32x4 v[4], xv[4]; float ss = 0.f;
#pragma unroll
            for (int j = 0; j < 4; ++j) { v[j] = yr[64 * j]; xv[j] = xr[64 * j]; ss += (v[j][0] * v[j][0] + v[j][1] * v[j][1]) + (v[j][2] * v[j][2] + v[j][3] * v[j][3]); }
            const float rstd = rsqrtf(wave_sum(ss) * (1.0f / D) + 1e-6f);
            f32x4* orow = (f32x4*)(F.out + m * D) + F.lane;
#pragma unroll
            for (int j = 0; j < 4; ++j) orow[64 * j] = xv[j] + v[j] * rstd * cg[j];
        }
    }
}

struct Args { const float* in[15]; float* out; unsigned char* ws; int ph_lo, ph_hi; };
__global__ void __launch_bounds__(512, 2) mk_fwd(Args args) {
    extern __shared__ __attribute__((aligned(16))) unsigned char lds_raw[];
    Frame F;
    F.lds = (LAS unsigned char*)lds_raw;
    F.MISC = (volatile LAS unsigned*)(F.lds + MISC_OFF);
    F.tid = threadIdx.x; F.lane = F.tid & 63; F.wave = __builtin_amdgcn_readfirstlane(F.tid >> 6);
    F.G = gridDim.x; { const int bx = blockIdx.x; F.vcu = (F.G % 8 == 0) ? (bx % 8) * (F.G / 8) + bx / 8 : bx; }
    unsigned char* ws = args.ws;
    F.ctl = (unsigned*)(ws + WS_CTL);
    F.x = args.in[0]; F.c = args.in[1]; F.pos = (const int*)args.in[2]; F.w_ada = args.in[3]; F.b_ada = args.in[4]; F.pre_g = args.in[5]; F.w_in = args.in[6];
    F.conv_w = args.in[7]; F.conv_b = args.in[8]; F.ln_g = args.in[9]; F.ln_b = args.in[10]; F.w_ret = args.in[11]; F.w_conv = args.in[12]; F.w_out = args.in[13]; F.post_g = args.in[14];
    F.out = args.out; F.mod = (float*)(ws + WS_MOD);
    F.WIN = (bf16*)(ws + WS_WIN); F.WRET = (bf16*)(ws + WS_WRET); F.WCONV = (bf16*)(ws + WS_WCONV); F.WOUT = (bf16*)(ws + WS_WOUT);
    F.H = (bf16*)(ws + WS_H); F.Q = (bf16*)(ws + WS_Q); F.K = (bf16*)(ws + WS_K); F.V = (bf16*)(ws + WS_V); F.ZR = (bf16*)(ws + WS_ZR);
    F.SGA = (bf16*)args.out; F.SGB = (bf16*)args.out + (size_t)M * 1024; F.F32S = (float*)(ws + WS_V);
    for (int u = F.tid; u < (LDS_BYTES - LDSCTL_OFF) / 4; u += 512) ((LAS unsigned*)(F.lds + LDSCTL_OFF))[u] = 0u;
    __syncthreads();
    const int lo = args.ph_lo, hi = args.ph_hi;
    XcdBarrier bar; bar.bar = (unsigned*)(F.ctl + CW_BAR); bar.x = 0; bar.st = nullptr;
    if (hi - lo > 1) bar = xcd_barrier_post((unsigned*)(F.ctl + CW_BAR), F.MISC + 8);
#define IN(k) (lo <= (k) && (k) < hi)
#define SEAM(k) do { if (IN(k) && IN((k) + 1)) xcd_barrier(bar); } while (0)
    if (IN(0)) { phase0(F); } SEAM(0);
    if (IN(1)) { phase1(F); } SEAM(1);
    if (IN(2)) {
        pg8::Gemm g{F.H, F.WIN, M, NT1 * 256, 1024}; pg8::StaticOrder S; S.init(M, NT1 * 256, F.G, (int)blockIdx.x);
        EpiProj1 E{F.Q, F.K, F.V, F.ZR, F.pos};
        pg8::gemm_phase<EpiProj1, pg8::StaticOrder, true, true>(F.lds, g, S, E);
    } SEAM(2);
    if (IN(3)) { phase3(F); } SEAM(3);
    if (IN(4)) {
        pg8::Gemm g{F.H, F.WIN + (size_t)NT1 * 256 * 1024, M, NT2 * 256, 1024}; pg8::StaticOrder S; S.init(M, NT2 * 256, F.G, (int)blockIdx.x);
        EpiProj2 E{F.Q, F.K, F.SGA, F.SGB};
        pg8::gemm_phase<EpiProj2, pg8::StaticOrder, true, true>(F.lds, g, S, E);
    } SEAM(4);
    if (IN(5)) { gn_pass(F); conv_pass(F); } SEAM(5);
    if (IN(6)) {
        pg8::StaticOrder S; S.init(M, 1024, F.G, (int)blockIdx.x);
        { pg8::Gemm g{F.ZR, F.WRET, M, 1024, 2048}; EpiYa E{F.F32S, F.SGA}; pg8::gemm_phase<EpiYa, pg8::StaticOrder, true, true>(F.lds, g, S, E); }
        { pg8::Gemm g{F.K, F.WCONV, M, 1024, 1024}; EpiYb E{F.F32S, F.SGB, F.H}; pg8::gemm_phase<EpiYb, pg8::StaticOrder, true, true>(F.lds, g, S, E); }
    } SEAM(6);
    if (IN(7)) {
        pg8::Gemm g{F.H, F.WOUT, M, 1024, 1024}; pg8::StaticOrder S; S.init(M, 1024, F.G, (int)blockIdx.x);
        EpiY E{F.F32S};
        pg8::gemm_phase<EpiY, pg8::StaticOrder, true, true>(F.lds, g, S, E);
    } SEAM(7);
    if (IN(8)) { phase8(F); }
#undef IN
#undef SEAM
}


__global__ void mk_dump(const unsigned char* ws, float* out, int which) {
    const size_t i = (size_t)blockIdx.x * blockDim.x + threadIdx.x;
    if (i >= (size_t)M * 1024) return;
    const size_t m = i >> 10, c = i & 1023;
    const bf16* Q = (const bf16*)(ws + WS_Q); const bf16* K = (const bf16*)(ws + WS_K); const bf16* V = (const bf16*)(ws + WS_V); const bf16* ZR = (const bf16*)(ws + WS_ZR); const bf16* H = (const bf16*)(ws + WS_H);
    float r = 0.f;
    auto f = [](bf16 v) { return __uint_as_float(((unsigned)v) << 16); };
    if (which == 0) r = f(H[i]);
    if (which == 1) r = f(Q[i]) + f(K[i]) + f(V[m * 2048 + c]) + f(V[m * 2048 + 1024 + c]) + f(ZR[m * 2048 + c]) + f(ZR[m * 2048 + 1024 + c]);
    if (which == 2) r = f(V[m * 2048 + c]) + f(V[m * 2048 + 1024 + c]);
    if (which == 3) r = f(Q[i]) + f(K[i]);
    if (which == 4) r = f(K[i]) + f(ZR[m * 2048 + c]) + f(ZR[m * 2048 + 1024 + c]);
    if (which == 5) r = f(H[i]);
    if (which == 6) r = ((const float*)(ws + WS_V))[i];
    out[i] = r;
}
#ifndef MK_SPLIT
#define MK_SPLIT 1
#endif
extern "C" void kernel_launch(void* const* d_in, const int* in_sizes, int n_in, void* d_out, int out_size, void* d_ws, size_t ws_size, hipStream_t stream) {
    static int grid = 0;
    if (grid == 0) {
        if (n_in != 15 || in_sizes[0] != M * D || out_size != M * D || ws_size < WS_END) { fprintf(stderr, "kernel_launch: unexpected shapes (n_in %d, in0 %d, out %d, ws %zu)\n", n_in, n_in > 0 ? in_sizes[0] : -1, out_size, ws_size); grid = -1; return; }
        int dev = 0, cus = 0;
        if (hipGetDevice(&dev) != hipSuccess || hipDeviceGetAttribute(&cus, hipDeviceAttributeMultiprocessorCount, dev) != hipSuccess) { grid = -1; return; }
        if (hipFuncSetAttribute((const void*)mk_fwd, hipFuncAttributeMaxDynamicSharedMemorySize, LDS_BYTES) != hipSuccess) { fprintf(stderr, "kernel_launch: hipFuncSetAttribute failed\n"); grid = -1; return; }
        grid = cus;
    }
    if (grid < 0) return;
    (void)hipMemsetAsync((char*)d_ws + WS_CTL, 0, CTL_BYTES, stream);
    Args a{};
    for (int i = 0; i < 15; ++i) a.in[i] = (const float*)d_in[i];
    a.out = (float*)d_out; a.ws = (unsigned char*)d_ws;
#if MK_SPLIT
#ifdef MK_DUMP_AFTER
    for (int p = 0; p <= MK_DUMP_AFTER; ++p) { a.ph_lo = p; a.ph_hi = p + 1; hipLaunchKernelGGL(mk_fwd, dim3(grid), dim3(512), LDS_BYTES, stream, a); }
    hipLaunchKernelGGL(mk_dump, dim3(M * 1024 / 256), dim3(256), 0, stream, (const unsigned char*)d_ws, (float*)d_out, MK_DUMP_WHICH);
#else
    for (int p = 0; p < NPHASE; ++p) { a.ph_lo = p; a.ph_hi = p + 1; hipLaunchKernelGGL(mk_fwd, dim3(grid), dim3(512), LDS_BYTES, stream, a); }
#endif
#else
    a.ph_lo = 0; a.ph_hi = NPHASE; hipLaunchKernelGGL(mk_fwd, dim3(grid), dim3(512), LDS_BYTES, stream, a);
#endif
}
```

```cpp
#include <hip/hip_runtime.h>
#include <cstdio>
#include <cstdint>
namespace pg8 {
#define PG8_LAS __attribute__((address_space(3)))
typedef unsigned short bf16_t;
typedef short bf16x8 __attribute__((ext_vector_type(8)));
typedef float f32x4 __attribute__((ext_vector_type(4)));
typedef unsigned u32x4 __attribute__((ext_vector_type(4)));
constexpr int BM = 256, BK = 64, HALF = 128, HTB = HALF * BK * 2  , STAGE_BYTES = 8 * HTB, NXCD = 8, WGM = 8;

__host__ __device__ __forceinline__ int lds_byte(int r, int c) { const int st = (r >> 4) * 2 + (c >> 5), rr = r & 15, cc = c & 31, ob = rr * 64 + cc * 2; return st * 1024 + (ob ^ (((ob >> 9) & 1) << 5)); }
__host__ __device__ __forceinline__ void stage_rc(int b, int& R, int& C) { const int st = b / 1024, sb = b % 1024, swz = sb ^ (((sb >> 9) & 1) << 5); R = (st >> 1) * 16 + swz / 64; C = (st & 1) * 32 + (swz % 64) / 2; }
__host__ __device__ __forceinline__ int perm32(int rho) { const int n = rho >> 4, i = rho & 15; return 8 * (i >> 2) + 4 * n + (i & 3); }

struct Unit { int pm, pn; };
struct Gemm { const bf16_t* A; const bf16_t* Bt; int M, N, K; };

struct StaticOrder {
    int nM, nN, nwg, G, c;
    __host__ __device__ void init(int M, int N, int G_, int c_) { nM = M / BM; nN = N / BM; nwg = nM * nN; G = G_; c = c_; }
    __host__ __device__ bool next(int i, Unit& u) const {
        const long L = (long)i * G + c; if (L >= nwg) return false;
        int wgid = (int)L; { const int q = nwg / NXCD, r = nwg % NXCD, xcd = wgid % NXCD, off = wgid / NXCD; wgid = (xcd < r ? xcd * (q + 1) : r * (q + 1) + (xcd - r) * q) + off; }
        const int nig = WGM * nN, gid = wgid / nig, fm = gid * WGM, gsz = (nM - fm) < WGM ? (nM - fm) : WGM;
        u.pm = fm + ((wgid % nig) % gsz); u.pn = (wgid % nig) / gsz; return true;
    }
    __device__ __forceinline__ void a_ready(const Unit&) const {}
    __device__ __forceinline__ void done(const Unit&) const {}
};
__device__ __forceinline__ unsigned cvt_pk_bf16(float lo, float hi) { unsigned r; asm volatile("v_cvt_pk_bf16_f32 %0, %1, %2" : "=v"(r) : "v"(lo), "v"(hi)); return r; }
template <class Epi, class Sched, bool ALIGN_EPI = false, bool SP2 = false>
__device__ __forceinline__ void gemm_phase(PG8_LAS unsigned char* lds, const Gemm g, const Sched& S, const Epi& E) {
    const int tid = threadIdx.x, wid = __builtin_amdgcn_readfirstlane(tid >> 6), lane = tid & 63, wr = wid >> 2, wc = wid & 3, fr = lane & 15, fq = lane >> 4;
    const int K = g.K, nt = K / BK;
    unsigned voffA[2], voffB[2];
#pragma unroll
    for (int i = 0; i < 2; ++i) { int R, C; stage_rc(tid * 16 + i * 8192, R, C); const int Rb = Epi::PERM ? ((R & ~31) + perm32(R & 31)) : R;
        voffA[i] = (unsigned)(R * K + C) * 2u; voffB[i] = (unsigned)(Rb * K + C) * 2u; }
    const size_t kstep = (size_t)(BK * 2);
    const size_t hstep = (size_t)HALF * K * 2;
    const size_t tstep = 2 * hstep;
    const unsigned ldsw = (unsigned)wid * 1024u;
    const int aoff = lds_byte(wr * 64 + fr, fq * 8), boff = lds_byte(wc * 32 + fr, fq * 8);
#define PG8_SA(b, h) (((b) * 2 + (h)) * HTB)
#define PG8_SB(b, h) ((4 + (b) * 2 + (h)) * HTB)
#define PG8_STAGE(bufoff, gbase, voff) do { _Pragma("unroll") for (int _i = 0; _i < 2; ++_i) \
        __builtin_amdgcn_global_load_lds((const unsigned*)((const char*)(gbase) + (voff)[_i]), (PG8_LAS unsigned*)(lds + (bufoff) + ldsw + _i * 8192), 16, 0, 0); } while (0)
#define PG8_LDA(dst, b, h) do { _Pragma("unroll") for (int m = 0; m < 4; ++m) _Pragma("unroll") for (int k = 0; k < 2; ++k) dst[m][k] = *(const PG8_LAS bf16x8*)(lds + PG8_SA(b, h) + aoff + m * 2048 + k * 1024); } while (0)
#define PG8_LDB(dst, b, h) do { _Pragma("unroll") for (int n = 0; n < 2; ++n) _Pragma("unroll") for (int k = 0; k < 2; ++k) dst[n][k] = *(const PG8_LAS bf16x8*)(lds + PG8_SB(b, h) + boff + n * 2048 + k * 1024); } while (0)
#define PG8_MMA(ai, bj, At, Bt) do { __builtin_amdgcn_s_setprio(1); _Pragma("unroll") for (int m = 0; m < 4; ++m) _Pragma("unroll") for (int n = 0; n < 2; ++n) _Pragma("unroll") for (int k = 0; k < 2; ++k) \
        acc[ai][bj][m][n] = __builtin_amdgcn_mfma_f32_16x16x32_bf16(Bt[n][k], At[m][k], acc[ai][bj][m][n], 0, 0, 0); __builtin_amdgcn_s_setprio(0); } while (0)
#define PG8_WAIT_V(n) asm volatile("s_waitcnt vmcnt(" #n ")" ::: "memory")
#define PG8_WAIT_L(n) asm volatile("s_waitcnt lgkmcnt(" #n ")" ::: "memory")
#define PG8_BAR __builtin_amdgcn_s_barrier()
#define PG8_SCHED __builtin_amdgcn_sched_barrier(0)
    Unit cur, nxt; int ui = 0;
    if (!S.next(0, cur)) return;
    f32x4 acc[2][2][4][2];
#pragma unroll
    for (int a = 0; a < 2; ++a)
#pragma unroll
        for (int b = 0; b < 2; ++b)
#pragma unroll
            for (int m = 0; m < 4; ++m)
#pragma unroll
                for (int n = 0; n < 2; ++n) acc[a][b][m][n] = (f32x4){0.f, 0.f, 0.f, 0.f};
    bf16x8 At[4][2], B0[2][2], B1[2][2];
    const char* cA = (const char*)g.A + (size_t)cur.pm * tstep; const char* cB = (const char*)g.Bt + (size_t)cur.pn * tstep;
    S.a_ready(cur);
    if constexpr (SP2) {
        PG8_STAGE(PG8_SB(0, 0), cB, voffB); PG8_STAGE(PG8_SB(0, 1), cB + hstep, voffB); PG8_STAGE(PG8_SA(0, 0), cA, voffA); PG8_STAGE(PG8_SA(0, 1), cA + hstep, voffA);
        if (wr == 1) PG8_BAR;
        PG8_WAIT_V(2); PG8_BAR;
        PG8_STAGE(PG8_SB(1, 0), cB + kstep, voffB); PG8_STAGE(PG8_SA(1, 0), cA + kstep, voffA); PG8_STAGE(PG8_SB(1, 1), cB + hstep + kstep, voffB);
        PG8_WAIT_V(6); PG8_BAR;
    } else {
        PG8_STAGE(PG8_SB(0, 0), cB, voffB); PG8_STAGE(PG8_SA(0, 0), cA, voffA); PG8_STAGE(PG8_SB(0, 1), cB + hstep, voffB); PG8_STAGE(PG8_SA(0, 1), cA + hstep, voffA);
        if (wr == 1) PG8_BAR;
        PG8_WAIT_V(4); PG8_BAR;
        PG8_STAGE(PG8_SB(1, 0), cB + kstep, voffB); PG8_STAGE(PG8_SA(1, 0), cA + kstep, voffA); PG8_STAGE(PG8_SB(1, 1), cB + hstep + kstep, voffB);
        PG8_WAIT_V(6); PG8_BAR;
    }
    for (;;) {
        const bool has_next = S.next(ui + 1, nxt);
        const char* nA = has_next ? (const char*)g.A + (size_t)nxt.pm * tstep : cA; const char* nB = has_next ? (const char*)g.Bt + (size_t)nxt.pn * tstep : cB;
        for (int t = 0; t < nt; t += 2) {
            const bool last = (t == nt - 2);
            const char* a1 = cA + (size_t)(t + 1) * kstep;
            const char* a2 = last ? nA : cA + (size_t)(t + 2) * kstep; const char* b2 = last ? nB : cB + (size_t)(t + 2) * kstep;
            const char* a3 = a2 + kstep; const char* b3 = b2 + kstep;
            if (last && has_next) S.a_ready(nxt);
            if constexpr (SP2) {
            PG8_LDB(B0, 0, 0); PG8_LDB(B1, 0, 1); PG8_SCHED; PG8_LDA(At, 0, 0); PG8_STAGE(PG8_SA(1, 1), a1 + hstep, voffA);
            PG8_WAIT_V(8); PG8_WAIT_L(0); PG8_BAR; PG8_MMA(0, 0, At, B0); PG8_MMA(0, 1, At, B1); PG8_BAR; PG8_SCHED;
            PG8_LDA(At, 0, 1); PG8_STAGE(PG8_SB(0, 0), b2, voffB); PG8_STAGE(PG8_SB(0, 1), b2 + hstep, voffB); PG8_STAGE(PG8_SA(0, 0), a2, voffA);
            PG8_WAIT_V(8); PG8_WAIT_L(0); PG8_BAR; PG8_MMA(1, 0, At, B0); PG8_MMA(1, 1, At, B1); PG8_BAR; PG8_SCHED;
            PG8_LDB(B0, 1, 0); PG8_LDB(B1, 1, 1); PG8_SCHED; PG8_LDA(At, 1, 0); PG8_STAGE(PG8_SA(0, 1), a2 + hstep, voffA);
            PG8_WAIT_V(8); PG8_WAIT_L(0); PG8_BAR; PG8_MMA(0, 0, At, B0); PG8_MMA(0, 1, At, B1); PG8_BAR; PG8_SCHED;
            PG8_LDA(At, 1, 1); PG8_STAGE(PG8_SB(1, 0), b3, voffB); PG8_STAGE(PG8_SB(1, 1), b3 + hstep, voffB); PG8_STAGE(PG8_SA(1, 0), a3, voffA);
            PG8_WAIT_V(8); PG8_WAIT_L(0); PG8_BAR; PG8_MMA(1, 0, At, B0); PG8_MMA(1, 1, At, B1); PG8_BAR; PG8_SCHED;
            } else {
            PG8_LDB(B0, 0, 0); PG8_SCHED; PG8_LDA(At, 0, 0); PG8_STAGE(PG8_SA(1, 1), a1 + hstep, voffA);
            PG8_WAIT_L(8); PG8_BAR; PG8_WAIT_L(0); PG8_MMA(0, 0, At, B0); PG8_BAR; PG8_SCHED;
            PG8_LDB(B1, 0, 1); PG8_STAGE(PG8_SB(0, 0), b2, voffB);
            PG8_BAR; PG8_WAIT_L(0); PG8_MMA(0, 1, At, B1); PG8_BAR;
            PG8_LDA(At, 0, 1); PG8_STAGE(PG8_SA(0, 0), a2, voffA);
            PG8_BAR; PG8_WAIT_L(0); PG8_MMA(1, 0, At, B0); PG8_BAR; PG8_SCHED;
            PG8_STAGE(PG8_SB(0, 1), b2 + hstep, voffB);
            PG8_WAIT_V(6); PG8_BAR; PG8_MMA(1, 1, At, B1); PG8_BAR;
            PG8_LDB(B0, 1, 0); PG8_SCHED; PG8_LDA(At, 1, 0); PG8_STAGE(PG8_SA(0, 1), a2 + hstep, voffA);
            PG8_WAIT_L(8); PG8_BAR; PG8_WAIT_L(0); PG8_MMA(0, 0, At, B0); PG8_BAR; PG8_SCHED;
            PG8_LDB(B1, 1, 1); PG8_STAGE(PG8_SB(1, 0), b3, voffB);
            PG8_BAR; PG8_WAIT_L(0); PG8_MMA(0, 1, At, B1); PG8_BAR;
            PG8_LDA(At, 1, 1); PG8_STAGE(PG8_SA(1, 0), a3, voffA);
            PG8_BAR; PG8_WAIT_L(0); PG8_MMA(1, 0, At, B0); PG8_BAR; PG8_SCHED;
            PG8_STAGE(PG8_SB(1, 1), b3 + hstep, voffB);
            PG8_WAIT_V(6); PG8_BAR; PG8_MMA(1, 1, At, B1); PG8_BAR;
            }
        }
        if constexpr (ALIGN_EPI) { if (wr == 0) PG8_BAR; }
        if constexpr (!Epi::AFTER_DRAIN) { E(acc, cur, wr, wc, fr, fq); S.done(cur); }
        if (!has_next) break;
#pragma unroll
        for (int a = 0; a < 2; ++a)
#pragma unroll
            for (int b = 0; b < 2; ++b)
#pragma unroll
                for (int m = 0; m < 4; ++m)
#pragma unroll
                    for (int n = 0; n < 2; ++n) acc[a][b][m][n] = (f32x4){0.f, 0.f, 0.f, 0.f};
        cur = nxt; cA = nA; cB = nB; ++ui;
        if constexpr (ALIGN_EPI) { if (wr == 1) PG8_BAR; }
    }
    PG8_WAIT_V(0);
    if constexpr (!ALIGN_EPI) { if (wr == 0) PG8_BAR; }
    PG8_BAR;
    if constexpr (Epi::AFTER_DRAIN) { E.fused(acc, cur, wr, wc, fr, fq, lds, wid, lane); S.done(cur); }
#undef PG8_SA
#undef PG8_SB
#undef PG8_STAGE
#undef PG8_LDA
#undef PG8_LDB
#undef PG8_MMA
#undef PG8_WAIT_V
#undef PG8_WAIT_L
#undef PG8_BAR
#undef PG8_SCHED
}
}

#define LAS __attribute__((address_space(3)))
typedef unsigned short bf16;
typedef pg8::f32x4 f32x4;
typedef pg8::u32x4 u32x4;
typedef pg8::bf16x8 bf16x8;
typedef unsigned u32x2 __attribute__((ext_vector_type(2)));
typedef float f32x2v __attribute__((ext_vector_type(2)));

constexpr int NB = 4, SEQ = 8192, D = 1024, M = NB * SEQ;
constexpr int NH = 4, DK = 256, DV = 512;
constexpr int NT1 = 24, NT2 = 20, NIN = (NT1 + NT2) * 256;
constexpr int NPHASE = 9;

constexpr size_t MiB = 1u << 20;
constexpr size_t WS_CTL = 0, CTL_BYTES = 1 * MiB;
constexpr size_t WS_MOD = 1 * MiB;
constexpr size_t WS_WIN = 2 * MiB;
constexpr size_t WS_WRET = 24 * MiB;
constexpr size_t WS_WCONV = 28 * MiB;
constexpr size_t WS_WOUT = 30 * MiB;
constexpr size_t WS_H = 32 * MiB;
constexpr size_t WS_Q = 96 * MiB;
constexpr size_t WS_K = 160 * MiB;
constexpr size_t WS_V = 224 * MiB;
constexpr size_t WS_ZR = 352 * MiB;
constexpr size_t WS_END = 480 * MiB;
constexpr int CW_BAR = 4096;

typedef float f32x2_t __attribute__((ext_vector_type(2)));
typedef __bf16 bf16x2_t __attribute__((ext_vector_type(2)));
__device__ __forceinline__ unsigned cvt_pk(float lo, float hi) { const f32x2_t v = {lo, hi}; const bf16x2_t b = __builtin_convertvector(v, bf16x2_t); return __builtin_bit_cast(unsigned, b); }
__device__ __forceinline__ float bf_lo(unsigned u) { return __uint_as_float(u << 16); }
__device__ __forceinline__ float bf_hi(unsigned u) { return __uint_as_float(u & 0xffff0000u); }
__device__ __forceinline__ float fsigmoid(float x) { return __builtin_amdgcn_rcpf(1.0f + __builtin_amdgcn_exp2f(x * -1.4426950408889634f)); }
__device__ __forceinline__ float fsilu(float x) { return x * fsigmoid(x); }

struct EpiProj1 {
    static constexpr bool PERM = true, AFTER_DRAIN = false;
    bf16* Q; bf16* K; bf16* V; bf16* ZR; const int* pos;
    __device__ __forceinline__ void operator()(const f32x4 (&acc)[2][2][4][2], const pg8::Unit& u, int wr, int wc, int fr, int fq) const {
        const int row0 = u.pm * 256 + wr * 64 + fr, cb = wc * 32 + 8 * fq, pn = u.pn;
        if (pn < 8) {
            bf16* base = (pn < 4 ? Q : K) + (pn & 3) * 256 + cb;
            const float sc = pn < 4 ? 1.0f : 0.0625f;
            float invf[8];
#pragma unroll
            for (int i = 0; i < 8; ++i) invf[i] = exp2f((float)(cb + i) * (-13.287712379549449f / 128.0f));
#pragma unroll
            for (int ai = 0; ai < 2; ++ai)
#pragma unroll
                for (int m = 0; m < 4; ++m) {
                    const int row = row0 + ai * 128 + m * 16;
                    const float p = (float)pos[row];
                    float o1[8], o2[8];
#pragma unroll
                    for (int n = 0; n < 2; ++n)
#pragma unroll
                        for (int j = 0; j < 4; ++j) {
                            const float ang = p * invf[n * 4 + j];
                            const float nn = rintf(ang * 0.15915494309189535f);
                            float r = fmaf(-nn, 6.2831854820251465f, ang);
                            r = fmaf(-nn, -1.7484555e-7f, r);
                            const float rv = r * 0.15915494309189535f;
                            const float s = __builtin_amdgcn_sinf(rv), c = __builtin_amdgcn_cosf(rv);
                            const float t1 = acc[ai][0][m][n][j], t2 = acc[ai][1][m][n][j];
                            o1[n * 4 + j] = (t1 * c - t2 * s) * sc; o2[n * 4 + j] = (t1 * s + t2 * c) * sc;
                        }
                    bf16* rp = base + (size_t)row * 1024;
                    u32x4 w1, w2;
                    w1.x = cvt_pk(o1[0], o1[1]); w1.y = cvt_pk(o1[2], o1[3]); w1.z = cvt_pk(o1[4], o1[5]); w1.w = cvt_pk(o1[6], o1[7]);
                    w2.x = cvt_pk(o2[0], o2[1]); w2.y = cvt_pk(o2[2], o2[3]); w2.z = cvt_pk(o2[4], o2[5]); w2.w = cvt_pk(o2[6], o2[7]);
                    *(u32x4*)rp = w1; *(u32x4*)(rp + 128) = w2;
                }
        } else {
            const bool act = pn >= 16;
            bf16* base = (act ? ZR + (pn - 16) * 256 : V + (pn - 8) * 256) + cb;
#pragma unroll
            for (int ai = 0; ai < 2; ++ai)
#pragma unroll
                for (int m = 0; m < 4; ++m) {
                    bf16* rp = base + (size_t)(row0 + ai * 128 + m * 16) * 2048;
#pragma unroll
                    for (int bj = 0; bj < 2; ++bj) {
                        f32x4 v0 = acc[ai][bj][m][0], v1 = acc[ai][bj][m][1];
                        if (act) {
#pragma unroll
                            for (int j = 0; j < 4; ++j) { v0[j] = fsilu(v0[j]); v1[j] = fsilu(v1[j]); }
                        }
                        u32x4 w; w.x = cvt_pk(v0[0], v0[1]); w.y = cvt_pk(v0[2], v0[3]); w.z = cvt_pk(v1[0], v1[1]); w.w = cvt_pk(v1[2], v1[3]);
                        *(u32x4*)(rp + bj * 128) = w;
                    }
                }
        }
    }
};
struct EpiProj2 {
    static constexpr bool PERM = true, AFTER_DRAIN = false;
    bf16* A; bf16* ZC; bf16* SGA; bf16* SGB;
    __device__ __forceinline__ void operator()(const f32x4 (&acc)[2][2][4][2], const pg8::Unit& u, int wr, int wc, int fr, int fq) const {
        const int row0 = u.pm * 256 + wr * 64 + fr, cb = wc * 32 + 8 * fq, pn = u.pn;
        if (pn < 8) {
            bf16* base = A + pn * 128 + cb;
#pragma unroll
            for (int ai = 0; ai < 2; ++ai)
#pragma unroll
                for (int m = 0; m < 4; ++m) {
                    f32x4 v0 = acc[ai][0][m][0], v1 = acc[ai][0][m][1]; const f32x4 g0 = acc[ai][1][m][0], g1 = acc[ai][1][m][1];
#pragma unroll
                    for (int j = 0; j < 4; ++j) { v0[j] *= fsigmoid(g0[j]); v1[j] *= fsigmoid(g1[j]); }
                    u32x4 w; w.x = cvt_pk(v0[0], v0[1]); w.y = cvt_pk(v0[2], v0[3]); w.z = cvt_pk(v1[0], v1[1]); w.w = cvt_pk(v1[2], v1[3]);
                    *(u32x4*)(base + (size_t)(row0 + ai * 128 + m * 16) * 1024) = w;
                }
        } else {
            const bool isz = pn < 12;
            bf16* base = (isz ? ZC + (pn - 8) * 256 : (pn < 16 ? SGA + (pn - 12) * 256 : SGB + (pn - 16) * 256)) + cb;
#pragma unroll
            for (int ai = 0; ai < 2; ++ai)
#pragma unroll
                for (int m = 0; m < 4; ++m) {
                    bf16* rp = base + (size_t)(row0 + ai * 128 + m * 16) * 1024;
#pragma unroll
                    for (int bj = 0; bj < 2; ++bj) {
                        f32x4 v0 = acc[ai][bj][m][0], v1 = acc[ai][bj][m][1];
#pragma unroll
                        for (int j = 0; j < 4; ++j) { const float s0 = fsigmoid(v0[j]), s1 = fsigmoid(v1[j]); v0[j] = isz ? v0[j] * s0 : s0; v1[j] = isz ? v1[j] * s1 : s1; }
                        u32x4 w; w.x = cvt_pk(v0[0], v0[1]); w.y = cvt_pk(v0[2], v0[3]); w.z = cvt_pk(v1[0], v1[1]); w.w = cvt_pk(v1[2], v1[3]);
                        *(u32x4*)(rp + bj * 128) = w;
                    }
                }
        }
    }
};
struct EpiYa {
    static constexpr bool PERM = true, AFTER_DRAIN = false;
    float* TA; const bf16* SGA;
    __device__ __forceinline__ void operator()(const f32x4 (&acc)[2][2][4][2], const pg8::Unit& u, int wr, int wc, int fr, int fq) const {
        const int row0 = u.pm * 256 + wr * 64 + fr, col0 = u.pn * 256 + wc * 32 + 8 * fq;
#pragma unroll
        for (int ai = 0; ai < 2; ++ai)
#pragma unroll
            for (int m = 0; m < 4; ++m) {
                const size_t ro = (size_t)(row0 + ai * 128 + m * 16) * 1024 + col0;
#pragma unroll
                for (int bj = 0; bj < 2; ++bj) {
                    const u32x4 g = *(const u32x4*)(SGA + ro + bj * 128);
                    f32x4 v0 = acc[ai][bj][m][0], v1 = acc[ai][bj][m][1];
                    v0[0] *= bf_lo(g.x); v0[1] *= bf_hi(g.x); v0[2] *= bf_lo(g.y); v0[3] *= bf_hi(g.y);
                    v1[0] *= bf_lo(g.z); v1[1] *= bf_hi(g.z); v1[2] *= bf_lo(g.w); v1[3] *= bf_hi(g.w);
                    *(f32x4*)(TA + ro + bj * 128) = v0; *(f32x4*)(TA + ro + bj * 128 + 4) = v1;
                }
            }
    }
};
struct EpiYb {
    static constexpr bool PERM = true, AFTER_DRAIN = false;
    const float* TA; const bf16* SGB; bf16* MG;
    __device__ __forceinline__ void operator()(const f32x4 (&acc)[2][2][4][2], const pg8::Unit& u, int wr, int wc, int fr, int fq) const {
        const int row0 = u.pm * 256 + wr * 64 + fr, col0 = u.pn * 256 + wc * 32 + 8 * fq;
#pragma unroll
        for (int ai = 0; ai < 2; ++ai)
#pragma unroll
            for (int m = 0; m < 4; ++m) {
                const size_t ro = (size_t)(row0 + ai * 128 + m * 16) * 1024 + col0;
#pragma unroll
                for (int bj = 0; bj < 2; ++bj) {
                    const u32x4 g = *(const u32x4*)(SGB + ro + bj * 128);
                    const f32x4 t0 = *(const f32x4*)(TA + ro + bj * 128), t1 = *(const f32x4*)(TA + ro + bj * 128 + 4);
                    f32x4 v0 = acc[ai][bj][m][0], v1 = acc[ai][bj][m][1];
                    v0[0] = t0[0] + v0[0] * bf_lo(g.x); v0[1] = t0[1] + v0[1] * bf_hi(g.x); v0[2] = t0[2] + v0[2] * bf_lo(g.y); v0[3] = t0[3] + v0[3] * bf_hi(g.y);
                    v1[0] = t1[0] + v1[0] * bf_lo(g.z); v1[1] = t1[1] + v1[1] * bf_hi(g.z); v1[2] = t1[2] + v1[2] * bf_lo(g.w); v1[3] = t1[3] + v1[3] * bf_hi(g.w);
                    u32x4 w; w.x = cvt_pk(v0[0], v0[1]); w.y = cvt_pk(v0[2], v0[3]); w.z = cvt_pk(v1[0], v1[1]); w.w = cvt_pk(v1[2], v1[3]);
                    *(u32x4*)(MG + ro + bj * 128) = w;
                }
            }
    }
};
struct EpiY {
    static constexpr bool PERM = true, AFTER_DRAIN = false;
    float* Y;
    __device__ __forceinline__ void operator()(const f32x4 (&acc)[2][2][4][2], const pg8::Unit& u, int wr, int wc, int fr, int fq) const {
        const int row0 = u.pm * 256 + wr * 64 + fr, col0 = u.pn * 256 + wc * 32 + 8 * fq;
#pragma unroll
        for (int ai = 0; ai < 2; ++ai)
#pragma unroll
            for (int m = 0; m < 4; ++m) {
                float* rp = Y + (size_t)(row0 + ai * 128 + m * 16) * 1024 + col0;
#pragma unroll
                for (int bj = 0; bj < 2; ++bj) { *(f32x4*)(rp + bj * 128) = acc[ai][bj][m][0]; *(f32x4*)(rp + bj * 128 + 4) = acc[ai][bj][m][1]; }
            }
    }
};
#define XB_TMO      128
#define XB_XCNT(j)  (256  + 64 * (j))
#define XB_XSUB(j)  (1280 + 64 * (j))
#define XB_XGEN(j)  (2304 + 64 * (j))
#define XB_TOP      3328
#define XB_TOPGEN   3392
#define XCD_BAR_WORDS 3456
#define XB_SPIN_CAP (1u << 18)

__device__ __forceinline__ unsigned xb_ld(unsigned* p)              { return __hip_atomic_load(p, __ATOMIC_RELAXED, __HIP_MEMORY_SCOPE_AGENT); }
__device__ __forceinline__ unsigned xb_add(unsigned* p, unsigned v) { return __hip_atomic_fetch_add(p, v, __ATOMIC_RELAXED, __HIP_MEMORY_SCOPE_AGENT); }
__device__ __forceinline__ unsigned xb_xcc_id() { return (unsigned)__builtin_amdgcn_s_getreg((3 << 11) | 20) & 0xFu; }
#define XB_SPIN(cond, bar) do { unsigned _sp = 0; while (cond) { __builtin_amdgcn_s_sleep(1); \
    if ((++_sp & 255u) == 0u) { if (xb_ld(&(bar)[XB_TMO])) break; if (_sp > XB_SPIN_CAP) { atomicAdd(&(bar)[XB_TMO], 1u); break; } } } } while (0)

struct XcdBarrier {
    unsigned* bar; unsigned x;
    volatile LAS unsigned* st;
};

__device__ __forceinline__ XcdBarrier xcd_barrier_post(unsigned* bar, volatile LAS unsigned* st) {
    XcdBarrier b; b.bar = bar; b.x = xb_xcc_id(); b.st = st;
    if (threadIdx.x == 0) (void)xb_add(&bar[XB_XCNT(b.x)], 1u);
    return b;
}
__device__ __forceinline__ void xcd_barrier_complete(unsigned* bar, unsigned x, unsigned& nloc, unsigned& nx) {
    const unsigned G = gridDim.x * gridDim.y * gridDim.z;
    unsigned sum, cnt, mine, sp = 0u;
    for (;;) {
        sum = 0u; cnt = 0u; mine = 0u;
#pragma unroll
        for (unsigned j = 0; j < 16; ++j) { const unsigned c = xb_ld(&bar[XB_XCNT(j)]); sum += c; cnt += (c > 0u) ? 1u : 0u; mine = (j == x) ? c : mine; }
        if (sum == G) break;
        __builtin_amdgcn_s_sleep(1);
        if ((++sp & 255u) == 0u) { if (xb_ld(&bar[XB_TMO])) break; if (sp > XB_SPIN_CAP) { atomicAdd(&bar[XB_TMO], 1u); break; } }
    }
    nloc = mine > 0u ? mine : 1u; nx = cnt > 0u ? cnt : 1u;
}

__device__ __forceinline__ void xcd_barrier(const XcdBarrier& b) {
    asm volatile("s_waitcnt vmcnt(0)" ::: "memory");
    __syncthreads();
    if (threadIdx.x == 0) {
        unsigned* bar = b.bar;
        __builtin_amdgcn_s_waitcnt(0);
        unsigned nloc = b.st[0], nx = b.st[1];
        if (nloc == 0u) { xcd_barrier_complete(bar, b.x, nloc, nx); b.st[0] = nloc; b.st[1] = nx; }
        const unsigned old = xb_add(&bar[XB_XSUB(b.x)], 1u);
        const unsigned gen = old / nloc;
        if (old + 1u == (gen + 1u) * nloc) {
            __builtin_amdgcn_fence(__ATOMIC_RELEASE, "agent");
            asm volatile("s_waitcnt vmcnt(0)" ::: "memory");
            const unsigned og = xb_add(&bar[XB_TOP], 1u);
            const unsigned tg = og / nx;
            if (og + 1u == (tg + 1u) * nx) xb_add(&bar[XB_TOPGEN], 1u);
            else XB_SPIN(xb_ld(&bar[XB_TOPGEN]) == tg, bar);
            __builtin_amdgcn_fence(__ATOMIC_ACQUIRE, "agent");
            xb_add(&bar[XB_XGEN(b.x)], 1u);
            asm volatile("s_waitcnt vmcnt(0)" ::: "memory");
        } else {
            XB_SPIN(xb_ld(&bar[XB_XGEN(b.x)]) == gen, bar);
            __builtin_amdgcn_fence(__ATOMIC_ACQUIRE, "agent");
            asm volatile("s_waitcnt vmcnt(0)" ::: "memory");
        }
    }
    __syncthreads();
}

constexpr int RING_BYTES = 131072;
constexpr int LDSCTL_OFF = RING_BYTES, MISC_OFF = LDSCTL_OFF + 320;
constexpr int LDS_BYTES = 147456;
struct Frame {
    LAS unsigned char* lds;
    volatile LAS unsigned* MISC;
    unsigned* ctl;
    int tid, lane, wave, vcu, G;
    const float *x, *c, *w_ada, *b_ada, *pre_g, *w_in, *conv_w, *conv_b, *ln_g, *ln_b, *w_ret, *w_conv, *w_out, *post_g;
    const int* pos;
    float* out; float* mod;
    bf16 *WIN, *WRET, *WCONV, *WOUT, *H, *Q, *K, *V, *ZR, *SGA, *SGB;
    float* F32S;
};
__device__ __forceinline__ float wave_sum(float v) {
#pragma unroll
    for (int o = 1; o < 64; o <<= 1) v += __shfl_xor(v, o);
    return v;
}
#define LDS_WAIT() asm volatile("s_waitcnt lgkmcnt(0)" ::: "memory")

__device__ __forceinline__ void transpose_item(const float* W, int K, int N, bf16* WT, int dst_row0, int src_col0, int k0, LAS float* scr, int lane) {
#pragma unroll 8
    for (int i = 0; i < 32; ++i) { const int kk = 2 * i + (lane >> 5); scr[kk * 33 + (lane & 31)] = W[(size_t)(k0 + kk) * N + src_col0 + (lane & 31)]; }
    LDS_WAIT(); asm volatile("" ::: "memory");
    const int c = lane & 7;
#pragma unroll
    for (int j = 0; j < 4; ++j) { const int n = (lane >> 3) + 8 * j; const LAS float* s = scr + (8 * c) * 33 + n;
        u32x4 o; o.x = cvt_pk(s[0 * 33], s[1 * 33]); o.y = cvt_pk(s[2 * 33], s[3 * 33]); o.z = cvt_pk(s[4 * 33], s[5 * 33]); o.w = cvt_pk(s[6 * 33], s[7 * 33]);
        *(u32x4*)(WT + (size_t)(dst_row0 + n) * K + k0 + 8 * c) = o; }
    LDS_WAIT(); asm volatile("" ::: "memory");
}
__device__ __forceinline__ int win_src_col(int n0) {
    if (n0 >= 6144 && n0 < 8192) { const int t = (n0 - 6144) >> 8, wi = (n0 - 6144) & 255; return wi < 128 ? 6144 + 128 * t + wi : 7168 + 128 * t + (wi - 128); }
    return n0;
}
__device__ __forceinline__ void phase0(Frame& F) {
    LAS float* red = (LAS float*)F.lds;
    for (int cg = blockIdx.x; cg < 48; cg += F.G) {
        const int col = cg * 64 + F.lane; float a0 = 0.f, a1 = 0.f, a2 = 0.f, a3 = 0.f;
        const int kb = F.wave * 128;
#pragma unroll 16
        for (int k = 0; k < 128; ++k) { const float wv = F.w_ada[(size_t)(kb + k) * 3072 + col];
            a0 = fmaf(F.c[kb + k], wv, a0); a1 = fmaf(F.c[1024 + kb + k], wv, a1); a2 = fmaf(F.c[2048 + kb + k], wv, a2); a3 = fmaf(F.c[3072 + kb + k], wv, a3); }
        red[(F.wave * 4 + 0) * 64 + F.lane] = a0; red[(F.wave * 4 + 1) * 64 + F.lane] = a1; red[(F.wave * 4 + 2) * 64 + F.lane] = a2; red[(F.wave * 4 + 3) * 64 + F.lane] = a3;
        __syncthreads();
        if (F.wave < 4) { float s = 0.f;
#pragma unroll
            for (int w = 0; w < 8; ++w) s += red[(w * 4 + F.wave) * 64 + F.lane];
            F.mod[F.wave * 3072 + col] = s + F.b_ada[col]; }
        __syncthreads();
    }
    LAS float* scr = (LAS float*)(F.lds + F.wave * 8448);
    const int gw = F.vcu * 8 + F.wave, NGW = F.G * 8;
    constexpr int I_IN = 16 * 352, I_RET = 32 * 32, I_CV = 16 * 32, I_OUT = 16 * 32;
    for (int it = gw; it < I_IN + I_RET + I_CV + I_OUT; it += NGW) {
        int r = it;
        if (r < I_IN) { const int kb = r / 352, nb = r % 352; transpose_item(F.w_in, 1024, NIN, F.WIN, nb * 32, win_src_col(nb * 32), kb * 64, scr, F.lane); continue; } r -= I_IN;
        if (r < I_RET) { const int kb = r >> 5, nb = r & 31; transpose_item(F.w_ret, 2048, 1024, F.WRET, nb * 32, nb * 32, kb * 64, scr, F.lane); continue; } r -= I_RET;
        if (r < I_CV) { const int kb = r >> 5, nb = r & 31; transpose_item(F.w_conv, 1024, 1024, F.WCONV, nb * 32, nb * 32, kb * 64, scr, F.lane); continue; } r -= I_CV;
        { const int kb = r >> 5, nb = r & 31; transpose_item(F.w_out, 1024, 1024, F.WOUT, nb * 32, nb * 32, kb * 64, scr, F.lane); }
    }
}
__device__ __forceinline__ void phase1(Frame& F) {
    const int gw = F.vcu * 8 + F.wave, NGW = F.G * 8;
    for (int rb = gw; rb < M / 16; rb += NGW) {
        const int b = (rb * 16) / SEQ;
        f32x4 ca[4], cs[4];
#pragma unroll
        for (int j = 0; j < 4; ++j) { const int col = 4 * F.lane + 256 * j;
            const f32x4 g = *(const f32x4*)(F.pre_g + col), sc = *(const f32x4*)(F.mod + b * 3072 + 1024 + col);
            ca[j] = g * (sc + 1.0f); cs[j] = *(const f32x4*)(F.mod + b * 3072 + col); }
        for (int r = 0; r < 16; ++r) {
            const size_t m = (size_t)rb * 16 + r;
            const f32x4* xr = (const f32x4*)(F.x + m * D) + F.lane;
            f32x4 v[4]; float ss = 0.f;
#pragma unroll
            for (int j = 0; j < 4; ++j) { v[j] = xr[64 * j]; ss += (v[j][0] * v[j][0] + v[j][1] * v[j][1]) + (v[j][2] * v[j][2] + v[j][3] * v[j][3]); }
            const float rstd = rsqrtf(wave_sum(ss) * (1.0f / D) + 1e-6f);
            u32x2* o8 = (u32x2*)(F.H + m * D) + F.lane;
#pragma unroll
            for (int j = 0; j < 4; ++j) { const f32x4 y = v[j] * rstd * ca[j] + cs[j]; u32x2 w; w.x = cvt_pk(y[0], y[1]); w.y = cvt_pk(y[2], y[3]); o8[64 * j] = w; }
        }
    }
}
constexpr int RT_ROW = 544, RT_PROW = 160;
constexpr int RT_QS = 0, RT_KS = 64 * RT_ROW, RT_P = 2 * 64 * RT_ROW, RT_VT = RT_P + 64 * RT_PROW, RT_ST = RT_VT + 32 * RT_PROW, RT_STB = 32 * RT_ROW;
static_assert(RT_ST + 2 * RT_STB <= RING_BYTES, "retention LDS map");
typedef short v4i16_t __attribute__((ext_vector_type(4)));
__device__ __forceinline__ bf16x8 ldfrag(const LAS unsigned char* p) { return *(const LAS bf16x8*)p; }
__device__ __forceinline__ v4i16_t ldtr(const LAS unsigned char* p) { return __builtin_amdgcn_ds_read_tr16_b64_v4i16((LAS v4i16_t*)p); }
#define MFMA16(a, b, c) __builtin_amdgcn_mfma_f32_16x16x32_bf16(a, b, c, 0, 0, 0)
__device__ __forceinline__ void phase3(Frame& F) {
    LAS unsigned char* lds = F.lds;
    const int tid = F.tid, lane = F.lane, w = F.wave, fr = lane & 15, fq = lane >> 4;
    const int srow = tid >> 5, sc16 = tid & 31, vrow = tid >> 3, ve4 = (tid & 7) * 4;
    const int ib = w >> 1, eb = w & 1, il = ib * 16 + fr, jb0 = (w & 1) * 2;
    for (int item = F.vcu; item < 256; item += F.G) {
        const int bh = item >> 4, sl = item & 15, b = bh >> 2, h = bh & 3;
        const float l2g = log2f(1.0f - exp2f(-5.0f - (float)h));
        const bf16* Qg = F.Q + (size_t)b * SEQ * 1024 + h * 256;
        const bf16* Kg = F.K + (size_t)b * SEQ * 1024 + h * 256;
        bf16* Vg = F.V + (size_t)b * SEQ * 2048 + h * 512 + sl * 32;
        const float zeta = exp2f((float)(63 - vrow) * l2g);
        const float rs1 = exp2f((float)(il - 63) * l2g), xi = exp2f((float)(il + 1) * l2g), gC = exp2f(64.0f * l2g);
        f32x4 st[2][2];
#pragma unroll
        for (int a = 0; a < 2; ++a)
#pragma unroll
            for (int e = 0; e < 2; ++e) st[a][e] = (f32x4){0.f, 0.f, 0.f, 0.f};
        for (int i = tid; i < RT_STB / 16; i += 512) *(LAS u32x4*)(lds + RT_ST + i * 16) = (u32x4){0u, 0u, 0u, 0u};
        u32x4 pq[4], pk[4]; u32x2 pv;
#pragma unroll
        for (int i = 0; i < 4; ++i) { pq[i] = *(const u32x4*)(Qg + (size_t)(srow + 16 * i) * 1024 + sc16 * 8); pk[i] = *(const u32x4*)(Kg + (size_t)(srow + 16 * i) * 1024 + sc16 * 8); }
        pv = *(const u32x2*)(Vg + (size_t)vrow * 2048 + ve4);
        for (int n = 0; n < SEQ / 64; ++n) {
            const int cur = n & 1, nxt = cur ^ 1;
#pragma unroll
            for (int i = 0; i < 4; ++i) { *(LAS u32x4*)(lds + RT_QS + (srow + 16 * i) * RT_ROW + sc16 * 16) = pq[i]; *(LAS u32x4*)(lds + RT_KS + (srow + 16 * i) * RT_ROW + sc16 * 16) = pk[i]; }
            { const unsigned z01 = cvt_pk(bf_lo(pv.x) * zeta, bf_hi(pv.x) * zeta), z23 = cvt_pk(bf_lo(pv.y) * zeta, bf_hi(pv.y) * zeta);
              LAS unsigned short* vt = (LAS unsigned short*)(lds + RT_VT + ve4 * RT_PROW + vrow * 2);
              vt[0] = (unsigned short)(z01 & 0xffffu); vt[RT_PROW / 2] = (unsigned short)(z01 >> 16); vt[RT_PROW] = (unsigned short)(z23 & 0xffffu); vt[3 * RT_PROW / 2] = (unsigned short)(z23 >> 16); }
            __syncthreads();
            if (n + 1 < SEQ / 64) {
                const size_t r0 = (size_t)(n + 1) * 64;
#pragma unroll
                for (int i = 0; i < 4; ++i) { pq[i] = *(const u32x4*)(Qg + (r0 + srow + 16 * i) * 1024 + sc16 * 8); pk[i] = *(const u32x4*)(Kg + (r0 + srow + 16 * i) * 1024 + sc16 * 8); }
                pv = *(const u32x2*)(Vg + (r0 + vrow) * 2048 + ve4);
            }
            const LAS unsigned char* qrow = lds + RT_QS + il * RT_ROW + fq * 16;
            {
                f32x4 s0 = (f32x4){0.f, 0.f, 0.f, 0.f}, s1 = (f32x4){0.f, 0.f, 0.f, 0.f};
                const LAS unsigned char* krow = lds + RT_KS + (jb0 * 16 + fr) * RT_ROW + fq * 16;
#pragma unroll
                for (int ks = 0; ks < 8; ++ks) { const bf16x8 qf = ldfrag(qrow + ks * 64), k0 = ldfrag(krow + ks * 64), k1 = ldfrag(krow + 16 * RT_ROW + ks * 64);
                    s0 = MFMA16(k0, qf, s0); s1 = MFMA16(k1, qf, s1); }
                const int j0 = jb0 * 16 + 4 * fq;
#pragma unroll
                for (int x = 0; x < 4; ++x) { if (j0 + x > il) s0[x] = 0.f; if (j0 + 16 + x > il) s1[x] = 0.f; }
                u32x2 p0, p1; p0.x = cvt_pk(s0[0], s0[1]); p0.y = cvt_pk(s0[2], s0[3]); p1.x = cvt_pk(s1[0], s1[1]); p1.y = cvt_pk(s1[2], s1[3]);
                *(LAS u32x2*)(lds + RT_P + il * RT_PROW + j0 * 2) = p0; *(LAS u32x2*)(lds + RT_P + il * RT_PROW + (j0 + 16) * 2) = p1;
            }
            __syncthreads();
            {
                f32x4 aP = (f32x4){0.f, 0.f, 0.f, 0.f}, aQ = (f32x4){0.f, 0.f, 0.f, 0.f};
                const LAS unsigned char* vtrow = lds + RT_VT + (eb * 16 + fr) * RT_PROW + fq * 16;
                const LAS unsigned char* prow = lds + RT_P + il * RT_PROW + fq * 16;
#pragma unroll
                for (int ks = 0; ks < 2; ++ks) aP = MFMA16(ldfrag(vtrow + ks * 64), ldfrag(prow + ks * 64), aP);
                const LAS unsigned char* strow = lds + RT_ST + cur * RT_STB + (eb * 16 + fr) * RT_ROW + fq * 16;
#pragma unroll
                for (int ks = 0; ks < 8; ++ks) aQ = MFMA16(ldfrag(strow + ks * 64), ldfrag(qrow + ks * 64), aQ);
                u32x2 o; o.x = cvt_pk(rs1 * aP[0] + xi * aQ[0], rs1 * aP[1] + xi * aQ[1]); o.y = cvt_pk(rs1 * aP[2] + xi * aQ[2], rs1 * aP[3] + xi * aQ[3]);
                *(u32x2*)(Vg + ((size_t)n * 64 + il) * 2048 + eb * 16 + 4 * fq) = o;
            }
            {
#pragma unroll
                for (int a = 0; a < 2; ++a)
#pragma unroll
                    for (int e = 0; e < 2; ++e) st[a][e] = st[a][e] * gC;
                const int q4 = fr >> 2, p4 = fr & 3;
#pragma unroll
                for (int ks = 0; ks < 2; ++ks) {
                    bf16x8 vf[2];
#pragma unroll
                    for (int e = 0; e < 2; ++e) vf[e] = ldfrag(lds + RT_VT + (e * 16 + fr) * RT_PROW + fq * 16 + ks * 64);
#pragma unroll
                    for (int a = 0; a < 2; ++a) {
                        const LAS unsigned char* kp = lds + RT_KS + (32 * ks + 8 * fq + q4) * RT_ROW + 32 * (2 * w + a) + 8 * p4;
                        const v4i16_t t0 = ldtr(kp), t1 = ldtr(kp + 4 * RT_ROW);
                        bf16x8 kf; kf[0] = t0[0]; kf[1] = t0[1]; kf[2] = t0[2]; kf[3] = t0[3]; kf[4] = t1[0]; kf[5] = t1[1]; kf[6] = t1[2]; kf[7] = t1[3];
#pragma unroll
                        for (int e = 0; e < 2; ++e) st[a][e] = MFMA16(kf, vf[e], st[a][e]);
                    }
                }
#pragma unroll
                for (int a = 0; a < 2; ++a)
#pragma unroll
                    for (int e = 0; e < 2; ++e) { u32x2 sv; sv.x = cvt_pk(st[a][e][0], st[a][e][1]); sv.y = cvt_pk(st[a][e][2], st[a][e][3]);
                        *(LAS u32x2*)(lds + RT_ST + nxt * RT_STB + (e * 16 + fr) * RT_ROW + (16 * (2 * w + a) + 4 * fq) * 2) = sv; }
            }
            __syncthreads();
        }
    }
}
__device__ __forceinline__ void gn_pass(Frame& F) {
    const int gw = F.vcu * 8 + F.wave, NGW = F.G * 8;
    for (int p = gw; p < M * NH; p += NGW) {
        const size_t off = (size_t)(p >> 2) * 2048 + (p & 3) * 512 + F.lane * 8;
        const u32x4 o = *(const u32x4*)(F.V + off), z = *(const u32x4*)(F.ZR + off);
        float v[8] = {bf_lo(o.x), bf_hi(o.x), bf_lo(o.y), bf_hi(o.y), bf_lo(o.z), bf_hi(o.z), bf_lo(o.w), bf_hi(o.w)};
        const float zf[8] = {bf_lo(z.x), bf_hi(z.x), bf_lo(z.y), bf_hi(z.y), bf_lo(z.z), bf_hi(z.z), bf_lo(z.w), bf_hi(z.w)};
        float s = 0.f;
#pragma unroll
        for (int i = 0; i < 8; ++i) s += v[i];
        const float mean = wave_sum(s) * (1.0f / 512.0f); float q = 0.f;
#pragma unroll
        for (int i = 0; i < 8; ++i) { v[i] -= mean; q += v[i] * v[i]; }
        const float rstd = rsqrtf(wave_sum(q) * (1.0f / 512.0f) + 1e-5f);
        u32x4 r; r.x = cvt_pk(v[0] * rstd * zf[0], v[1] * rstd * zf[1]); r.y = cvt_pk(v[2] * rstd * zf[2], v[3] * rstd * zf[3]);
        r.z = cvt_pk(v[4] * rstd * zf[4], v[5] * rstd * zf[5]); r.w = cvt_pk(v[6] * rstd * zf[6], v[7] * rstd * zf[7]);
        *(u32x4*)(F.ZR + off) = r;
    }
}
__device__ __forceinline__ void conv_pass(Frame& F) {
    LAS float* red = (LAS float*)F.lds;
    const int t = F.tid, c0 = 2 * t;
    float w0[31], w1[31];
#pragma unroll
    for (int k = 0; k < 31; ++k) { const f32x2v wv = *(const f32x2v*)(F.conv_w + k * 1024 + c0); w0[k] = wv.x; w1[k] = wv.y; }
    const f32x2v cb = *(const f32x2v*)(F.conv_b + c0), lg = *(const f32x2v*)(F.ln_g + c0), lb = *(const f32x2v*)(F.ln_b + c0);
    const bf16* A = F.Q;
    bf16* ZC = F.K;
    for (int tile = F.vcu; tile < M / 128; tile += F.G) {
        const int tok0 = tile * 128, b = tok0 / SEQ, s0 = tok0 % SEQ;
        const bf16* Ab = A + (size_t)b * SEQ * 1024 + c0;
        for (int gi = 0; gi < 16; ++gi) {
            const int sf = s0 + 8 * gi;
            float in0[38], in1[38];
#pragma unroll
            for (int i = 0; i < 38; ++i) { const int s = sf - 30 + i; const int sc = s < 0 ? 0 : s;
                unsigned uu = *(const unsigned*)(Ab + (size_t)sc * 1024); if (s < 0) uu = 0u; in0[i] = bf_lo(uu); in1[i] = bf_hi(uu); }
            float a0[8], a1[8], ps[16];
#pragma unroll
            for (int j = 0; j < 8; ++j) { float x0 = cb.x, x1 = cb.y;
#pragma unroll
                for (int k = 0; k < 31; ++k) { x0 = fmaf(w0[k], in0[j + k], x0); x1 = fmaf(w1[k], in1[j + k], x1); }
                a0[j] = x0; a1[j] = x1; ps[j] = x0 + x1; ps[8 + j] = x0 * x0 + x1 * x1; }
#pragma unroll
            for (int j = 0; j < 16; ++j) ps[j] = wave_sum(ps[j]);
            if (F.lane < 16) { float v = ps[0];
#pragma unroll
                for (int j = 1; j < 16; ++j) v = (F.lane == j) ? ps[j] : v;
                red[F.wave * 16 + F.lane] = v; }
            __syncthreads();
            if (t < 16) { float s = 0.f;
#pragma unroll
                for (int w = 0; w < 8; ++w) s += red[w * 16 + t];
                red[128 + t] = s; }
            __syncthreads();
#pragma unroll
            for (int j = 0; j < 8; ++j) {
                const float mean = red[128 + j] * (1.0f / 1024.0f), var = red[136 + j] * (1.0f / 1024.0f) - mean * mean, rstd = rsqrtf(var + 1e-5f);
                const float y0 = (a0[j] - mean) * rstd * lg.x + lb.x, y1 = (a1[j] - mean) * rstd * lg.y + lb.y;
                unsigned* zp = (unsigned*)(ZC + (size_t)(tok0 + 8 * gi + j) * 1024 + c0);
                const unsigned zz = *zp;
                *zp = cvt_pk(fsilu(y0) * bf_lo(zz), fsilu(y1) * bf_hi(zz));
            }
        }
    }
    __syncthreads();
}
__device__ __forceinline__ void phase8(Frame& F) {
    const int gw = F.vcu * 8 + F.wave, NGW = F.G * 8;
    for (int rb = gw; rb < M / 16; rb += NGW) {
        const int b = (rb * 16) / SEQ;
        f32x4 cg[4];
#pragma unroll
        for (int j = 0; j < 4; ++j) { const int col = 4 * F.lane + 256 * j; cg[j] = *(const f32x4*)(F.post_g + col) * *(const f32x4*)(F.mod + b * 3072 + 2048 + col); }
        for (int r = 0; r < 16; ++r) {
            const size_t m = (size_t)rb * 16 + r;
            const f32x4* yr = (const f32x4*)(F.F32S + m * D) + F.lane; const f32x4* xr = (const f32x4*)(F.x + m * D) + F.lane;
            f32x4 v[4], xv[4]; float ss = 0.f;
#pragma unroll
            for (int j = 0; j < 4; ++j) { v[j] = yr[64 * j]; xv[j] = xr[64 * j]; ss += (v[j][0] * v[j][0] + v[j][1] * v[j][1]) + (v[j][2] * v[j][2] + v[j][3] * v[j][3]); }
            const float rstd = rsqrtf(wave_sum(ss) * (1.0f / D) + 1e-6f);
            f32x4* orow = (f32x4*)(F.out + m * D) + F.lane;
#pragma unroll
            for (int j = 0; j < 4; ++j) orow[64 * j] = xv[j] + v[j] * rstd * cg[j];
        }
    }
}

struct Args { const float* in[15]; float* out; unsigned char* ws; int ph_lo, ph_hi; };
__global__ void __launch_bounds__(512, 2) mk_fwd(Args args) {
    extern __shared__ __attribute__((aligned(16))) unsigned char lds_raw[];
    Frame F;
    F.lds = (LAS unsigned char*)lds_raw;
    F.MISC = (volatile LAS unsigned*)(F.lds + MISC_OFF);
    F.tid = threadIdx.x; F.lane = F.tid & 63; F.wave = __builtin_amdgcn_readfirstlane(F.tid >> 6);
    F.G = gridDim.x; { const int bx = blockIdx.x; F.vcu = (F.G % 8 == 0) ? (bx % 8) * (F.G / 8) + bx / 8 : bx; }
    unsigned char* ws = args.ws;
    F.ctl = (unsigned*)(ws + WS_CTL);
    F.x = args.in[0]; F.c = args.in[1]; F.pos = (const int*)args.in[2]; F.w_ada = args.in[3]; F.b_ada = args.in[4]; F.pre_g = args.in[5]; F.w_in = args.in[6];
    F.conv_w = args.in[7]; F.conv_b = args.in[8]; F.ln_g = args.in[9]; F.ln_b = args.in[10]; F.w_ret = args.in[11]; F.w_conv = args.in[12]; F.w_out = args.in[13]; F.post_g = args.in[14];
    F.out = args.out; F.mod = (float*)(ws + WS_MOD);
    F.WIN = (bf16*)(ws + WS_WIN); F.WRET = (bf16*)(ws + WS_WRET); F.WCONV = (bf16*)(ws + WS_WCONV); F.WOUT = (bf16*)(ws + WS_WOUT);
    F.H = (bf16*)(ws + WS_H); F.Q = (bf16*)(ws + WS_Q); F.K = (bf16*)(ws + WS_K); F.V = (bf16*)(ws + WS_V); F.ZR = (bf16*)(ws + WS_ZR);
    F.SGA = (bf16*)args.out; F.SGB = (bf16*)args.out + (size_t)M * 1024; F.F32S = (float*)(ws + WS_V);
    for (int u = F.tid; u < (LDS_BYTES - LDSCTL_OFF) / 4; u += 512) ((LAS unsigned*)(F.lds + LDSCTL_OFF))[u] = 0u;
    __syncthreads();
    const int lo = args.ph_lo, hi = args.ph_hi;
    XcdBarrier bar; bar.bar = (unsigned*)(F.ctl + CW_BAR); bar.x = 0; bar.st = nullptr;
    if (hi - lo > 1) bar = xcd_barrier_post((unsigned*)(F.ctl + CW_BAR), F.MISC + 8);
#define IN(k) (lo <= (k) && (k) < hi)
#define SEAM(k) do { if (IN(k) && IN((k) + 1)) xcd_barrier(bar); } while (0)
    if (IN(0)) { phase0(F); } SEAM(0);
    if (IN(1)) { phase1(F); } SEAM(1);
    if (IN(2)) {
        pg8::Gemm g{F.H, F.WIN, M, NT1 * 256, 1024}; pg8::StaticOrder S; S.init(M, NT1 * 256, F.G, (int)blockIdx.x);
        EpiProj1 E{F.Q, F.K, F.V, F.ZR, F.pos};
        pg8::gemm_phase<EpiProj1, pg8::StaticOrder, true, true>(F.lds, g, S, E);
    } SEAM(2);
    if (IN(3)) { phase3(F); } SEAM(3);
    if (IN(4)) {
        pg8::Gemm g{F.H, F.WIN + (size_t)NT1 * 256 * 1024, M, NT2 * 256, 1024}; pg8::StaticOrder S; S.init(M, NT2 * 256, F.G, (int)blockIdx.x);
        EpiProj2 E{F.Q, F.K, F.SGA, F.SGB};
        pg8::gemm_phase<EpiProj2, pg8::StaticOrder, true, true>(F.lds, g, S, E);
    } SEAM(4);
    if (IN(5)) { gn_pass(F); conv_pass(F); } SEAM(5);
    if (IN(6)) {
        pg8::StaticOrder S; S.init(M, 1024, F.G, (int)blockIdx.x);
        { pg8::Gemm g{F.ZR, F.WRET, M, 1024, 2048}; EpiYa E{F.F32S, F.SGA}; pg8::gemm_phase<EpiYa, pg8::StaticOrder, true, true>(F.lds, g, S, E); }
        { pg8::Gemm g{F.K, F.WCONV, M, 1024, 1024}; EpiYb E{F.F32S, F.SGB, F.H}; pg8::gemm_phase<EpiYb, pg8::StaticOrder, true, true>(F.lds, g, S, E); }
    } SEAM(6);
    if (IN(7)) {
        pg8::Gemm g{F.H, F.WOUT, M, 1024, 1024}; pg8::StaticOrder S; S.init(M, 1024, F.G, (int)blockIdx.x);
        EpiY E{F.F32S};
        pg8::gemm_phase<EpiY, pg8::StaticOrder, true, true>(F.lds, g, S, E);
    } SEAM(7);
    if (IN(8)) { phase8(F); }
#undef IN
#undef SEAM
}


__global__ void mk_dump(const unsigned char* ws, float* out, int which) {
    const size_t i = (size_t)blockIdx.x * blockDim.x + threadIdx.x;
    if (i >= (size_t)M * 1024) return;
    const size_t m = i >> 10, c = i & 1023;
    const bf16* Q = (const bf16*)(ws + WS_Q); const bf16* K = (const bf16*)(ws + WS_K); const bf16* V = (const bf16*)(ws + WS_V); const bf16* ZR = (const bf16*)(ws + WS_ZR); const bf16* H = (const bf16*)(ws + WS_H);
    float r = 0.f;
    auto f = [](bf16 v) { return __uint_as_float(((unsigned)v) << 16); };
    if (which == 0) r = f(H[i]);
    if (which == 1) r = f(Q[i]) + f(K[i]) + f(V[m * 2048 + c]) + f(V[m * 2048 + 1024 + c]) + f(ZR[m * 2048 + c]) + f(ZR[m * 2048 + 1024 + c]);
    if (which == 2) r = f(V[m * 2048 + c]) + f(V[m * 2048 + 1024 + c]);
    if (which == 3) r = f(Q[i]) + f(K[i]);
    if (which == 4) r = f(K[i]) + f(ZR[m * 2048 + c]) + f(ZR[m * 2048 + 1024 + c]);
    if (which == 5) r = f(H[i]);
    if (which == 6) r = ((const float*)(ws + WS_V))[i];
    out[i] = r;
}
#ifndef MK_SPLIT
#define MK_SPLIT 0
#endif
extern "C" void kernel_launch(void* const* d_in, const int* in_sizes, int n_in, void* d_out, int out_size, void* d_ws, size_t ws_size, hipStream_t stream) {
    static int grid = 0;
    if (grid == 0) {
        if (n_in != 15 || in_sizes[0] != M * D || out_size != M * D || ws_size < WS_END) { fprintf(stderr, "kernel_launch: unexpected shapes (n_in %d, in0 %d, out %d, ws %zu)\n", n_in, n_in > 0 ? in_sizes[0] : -1, out_size, ws_size); grid = -1; return; }
        int dev = 0, cus = 0;
        if (hipGetDevice(&dev) != hipSuccess || hipDeviceGetAttribute(&cus, hipDeviceAttributeMultiprocessorCount, dev) != hipSuccess) { grid = -1; return; }
        if (hipFuncSetAttribute((const void*)mk_fwd, hipFuncAttributeMaxDynamicSharedMemorySize, LDS_BYTES) != hipSuccess) { fprintf(stderr, "kernel_launch: hipFuncSetAttribute failed\n"); grid = -1; return; }
        grid = cus;
    }
    if (grid < 0) return;
    (void)hipMemsetAsync((char*)d_ws + WS_CTL, 0, CTL_BYTES, stream);
    Args a{};
    for (int i = 0; i < 15; ++i) a.in[i] = (const float*)d_in[i];
    a.out = (float*)d_out; a.ws = (unsigned char*)d_ws;
#if MK_SPLIT
#ifdef MK_DUMP_AFTER
    for (int p = 0; p <= MK_DUMP_AFTER; ++p) { a.ph_lo = p; a.ph_hi = p + 1; hipLaunchKernelGGL(mk_fwd, dim3(grid), dim3(512), LDS_BYTES, stream, a); }
    hipLaunchKernelGGL(mk_dump, dim3(M * 1024 / 256), dim3(256), 0, stream, (const unsigned char*)d_ws, (float*)d_out, MK_DUMP_WHICH);
#else
    for (int p = 0; p < NPHASE; ++p) { a.ph_lo = p; a.ph_hi = p + 1; hipLaunchKernelGGL(mk_fwd, dim3(grid), dim3(512), LDS_BYTES, stream, a); }
#endif
#else
    a.ph_lo = 0; a.ph_hi = NPHASE; hipLaunchKernelGGL(mk_fwd, dim3(grid), dim3(512), LDS_BYTES, stream, a);
#endif
}
```

```cpp
#include <hip/hip_runtime.h>
#include <cstdio>
#include <cstdint>
namespace pg8 {
#define PG8_LAS __attribute__((address_space(3)))
typedef unsigned short bf16_t;
typedef short bf16x8 __attribute__((ext_vector_type(8)));
typedef float f32x4 __attribute__((ext_vector_type(4)));
typedef unsigned u32x4 __attribute__((ext_vector_type(4)));
constexpr int BM = 256, BK = 64, HALF = 128, HTB = HALF * BK * 2  , STAGE_BYTES = 8 * HTB, NXCD = 8, WGM = 8;

__host__ __device__ __forceinline__ int lds_byte(int r, int c) { const int st = (r >> 4) * 2 + (c >> 5), rr = r & 15, cc = c & 31, ob = rr * 64 + cc * 2; return st * 1024 + (ob ^ (((ob >> 9) & 1) << 5)); }
__host__ __device__ __forceinline__ void stage_rc(int b, int& R, int& C) { const int st = b / 1024, sb = b % 1024, swz = sb ^ (((sb >> 9) & 1) << 5); R = (st >> 1) * 16 + swz / 64; C = (st & 1) * 32 + (swz % 64) / 2; }
__host__ __device__ __forceinline__ int perm32(int rho) { const int n = rho >> 4, i = rho & 15; return 8 * (i >> 2) + 4 * n + (i & 3); }

struct Unit { int pm, pn; };
struct Gemm { const bf16_t* A; const bf16_t* Bt; int M, N, K; };

struct StaticOrder {
    int nM, nN, nwg, G, c;
    __host__ __device__ void init(int M, int N, int G_, int c_) { nM = M / BM; nN = N / BM; nwg = nM * nN; G = G_; c = c_; }
    __host__ __device__ bool next(int i, Unit& u) const {
        const long L = (long)i * G + c; if (L >= nwg) return false;
        int wgid = (int)L; { const int q = nwg / NXCD, r = nwg % NXCD, xcd = wgid % NXCD, off = wgid / NXCD; wgid = (xcd < r ? xcd * (q + 1) : r * (q + 1) + (xcd - r) * q) + off; }
        const int nig = WGM * nN, gid = wgid / nig, fm = gid * WGM, gsz = (nM - fm) < WGM ? (nM - fm) : WGM;
        u.pm = fm + ((wgid % nig) % gsz); u.pn = (wgid % nig) / gsz; return true;
    }
    __device__ __forceinline__ void a_ready(const Unit&) const {}
    __device__ __forceinline__ void done(const Unit&) const {}
};
__device__ __forceinline__ unsigned cvt_pk_bf16(float lo, float hi) { unsigned r; asm volatile("v_cvt_pk_bf16_f32 %0, %1, %2" : "=v"(r) : "v"(lo), "v"(hi)); return r; }
template <class Epi, class Sched, bool ALIGN_EPI = false, bool SP2 = false>
__device__ __forceinline__ void gemm_phase(PG8_LAS unsigned char* lds, const Gemm g, const Sched& S, const Epi& E) {
    const int tid = threadIdx.x, wid = __builtin_amdgcn_readfirstlane(tid >> 6), lane = tid & 63, wr = wid >> 2, wc = wid & 3, fr = lane & 15, fq = lane >> 4;
    const int K = g.K, nt = K / BK;
    unsigned voffA[2], voffB[2];
#pragma unroll
    for (int i = 0; i < 2; ++i) { int R, C; stage_rc(tid * 16 + i * 8192, R, C); const int Rb = Epi::PERM ? ((R & ~31) + perm32(R & 31)) : R;
        voffA[i] = (unsigned)(R * K + C) * 2u; voffB[i] = (unsigned)(Rb * K + C) * 2u; }
    const size_t kstep = (size_t)(BK * 2);
    const size_t hstep = (size_t)HALF * K * 2;
    const size_t tstep = 2 * hstep;
    const unsigned ldsw = (unsigned)wid * 1024u;
    const int aoff = lds_byte(wr * 64 + fr, fq * 8), boff = lds_byte(wc * 32 + fr, fq * 8);
#define PG8_SA(b, h) (((b) * 2 + (h)) * HTB)
#define PG8_SB(b, h) ((4 + (b) * 2 + (h)) * HTB)
#define PG8_STAGE(bufoff, gbase, voff) do { _Pragma("unroll") for (int _i = 0; _i < 2; ++_i) \
        __builtin_amdgcn_global_load_lds((const unsigned*)((const char*)(gbase) + (voff)[_i]), (PG8_LAS unsigned*)(lds + (bufoff) + ldsw + _i * 8192), 16, 0, 0); } while (0)
#define PG8_LDA(dst, b, h) do { _Pragma("unroll") for (int m = 0; m < 4; ++m) _Pragma("unroll") for (int k = 0; k < 2; ++k) dst[m][k] = *(const PG8_LAS bf16x8*)(lds + PG8_SA(b, h) + aoff + m * 2048 + k * 1024); } while (0)
#define PG8_LDB(dst, b, h) do { _Pragma("unroll") for (int n = 0; n < 2; ++n) _Pragma("unroll") for (int k = 0; k < 2; ++k) dst[n][k] = *(const PG8_LAS bf16x8*)(lds + PG8_SB(b, h) + boff + n * 2048 + k * 1024); } while (0)
#define PG8_MMA(ai, bj, At, Bt) do { __builtin_amdgcn_s_setprio(1); _Pragma("unroll") for (int m = 0; m < 4; ++m) _Pragma("unroll") for (int n = 0; n < 2; ++n) _Pragma("unroll") for (int k = 0; k < 2; ++k) \
        acc[ai][bj][m][n] = __builtin_amdgcn_mfma_f32_16x16x32_bf16(Bt[n][k], At[m][k], acc[ai][bj][m][n], 0, 0, 0); __builtin_amdgcn_s_setprio(0); } while (0)
#define PG8_WAIT_V(n) asm volatile("s_waitcnt vmcnt(" #n ")" ::: "memory")
#define PG8_WAIT_L(n) asm volatile("s_waitcnt lgkmcnt(" #n ")" ::: "memory")
#define PG8_BAR __builtin_amdgcn_s_barrier()
#define PG8_SCHED __builtin_amdgcn_sched_barrier(0)
    Unit cur, nxt; int ui = 0;
    if (!S.next(0, cur)) return;
    f32x4 acc[2][2][4][2];
#pragma unroll
    for (int a = 0; a < 2; ++a)
#pragma unroll
        for (int b = 0; b < 2; ++b)
#pragma unroll
            for (int m = 0; m < 4; ++m)
#pragma unroll
                for (int n = 0; n < 2; ++n) acc[a][b][m][n] = (f32x4){0.f, 0.f, 0.f, 0.f};
    bf16x8 At[4][2], B0[2][2], B1[2][2];
    const char* cA = (const char*)g.A + (size_t)cur.pm * tstep; const char* cB = (const char*)g.Bt + (size_t)cur.pn * tstep;
    S.a_ready(cur);
    if constexpr (SP2) {
        PG8_STAGE(PG8_SB(0, 0), cB, voffB); PG8_STAGE(PG8_SB(0, 1), cB + hstep, voffB); PG8_STAGE(PG8_SA(0, 0), cA, voffA); PG8_STAGE(PG8_SA(0, 1), cA + hstep, voffA);
        if (wr == 1) PG8_BAR;
        PG8_WAIT_V(2); PG8_BAR;
        PG8_STAGE(PG8_SB(1, 0), cB + kstep, voffB); PG8_STAGE(PG8_SA(1, 0), cA + kstep, voffA); PG8_STAGE(PG8_SB(1, 1), cB + hstep + kstep, voffB);
        PG8_WAIT_V(6); PG8_BAR;
    } else {
        PG8_STAGE(PG8_SB(0, 0), cB, voffB); PG8_STAGE(PG8_SA(0, 0), cA, voffA); PG8_STAGE(PG8_SB(0, 1), cB + hstep, voffB); PG8_STAGE(PG8_SA(0, 1), cA + hstep, voffA);
        if (wr == 1) PG8_BAR;
        PG8_WAIT_V(4); PG8_BAR;
        PG8_STAGE(PG8_SB(1, 0), cB + kstep, voffB); PG8_STAGE(PG8_SA(1, 0), cA + kstep, voffA); PG8_STAGE(PG8_SB(1, 1), cB + hstep + kstep, voffB);
        PG8_WAIT_V(6); PG8_BAR;
    }
    for (;;) {
        const bool has_next = S.next(ui + 1, nxt);
        const char* nA = has_next ? (const char*)g.A + (size_t)nxt.pm * tstep : cA; const char* nB = has_next ? (const char*)g.Bt + (size_t)nxt.pn * tstep : cB;
        for (int t = 0; t < nt; t += 2) {
            const bool last = (t == nt - 2);
            const char* a1 = cA + (size_t)(t + 1) * kstep;
            const char* a2 = last ? nA : cA + (size_t)(t + 2) * kstep; const char* b2 = last ? nB : cB + (size_t)(t + 2) * kstep;
            const char* a3 = a2 + kstep; const char* b3 = b2 + kstep;
            if (last && has_next) S.a_ready(nxt);
            if constexpr (SP2) {
            PG8_LDB(B0, 0, 0); PG8_LDB(B1, 0, 1); PG8_SCHED; PG8_LDA(At, 0, 0); PG8_STAGE(PG8_SA(1, 1), a1 + hstep, voffA);
            PG8_WAIT_V(8); PG8_WAIT_L(0); PG8_BAR; PG8_MMA(0, 0, At, B0); PG8_MMA(0, 1, At, B1); PG8_BAR; PG8_SCHED;
            PG8_LDA(At, 0, 1); PG8_STAGE(PG8_SB(0, 0), b2, voffB); PG8_STAGE(PG8_SB(0, 1), b2 + hstep, voffB); PG8_STAGE(PG8_SA(0, 0), a2, voffA);
            PG8_WAIT_V(8); PG8_WAIT_L(0); PG8_BAR; PG8_MMA(1, 0, At, B0); PG8_MMA(1, 1, At, B1); PG8_BAR; PG8_SCHED;
            PG8_LDB(B0, 1, 0); PG8_LDB(B1, 1, 1); PG8_SCHED; PG8_LDA(At, 1, 0); PG8_STAGE(PG8_SA(0, 1), a2 + hstep, voffA);
            PG8_WAIT_V(8); PG8_WAIT_L(0); PG8_BAR; PG8_MMA(0, 0, At, B0); PG8_MMA(0, 1, At, B1); PG8_BAR; PG8_SCHED;
            PG8_LDA(At, 1, 1); PG8_STAGE(PG8_SB(1, 0), b3, voffB); PG8_STAGE(PG8_SB(1, 1), b3 + hstep, voffB); PG8_STAGE(PG8_SA(1, 0), a3, voffA);
            PG8_WAIT_V(8); PG8_WAIT_L(0); PG8_BAR; PG8_MMA(1, 0, At, B0); PG8_MMA(1, 1, At, B1); PG8_BAR; PG8_SCHED;
            } else {
            PG8_LDB(B0, 0, 0); PG8_SCHED; PG8_LDA(At, 0, 0); PG8_STAGE(PG8_SA(1, 1), a1 + hstep, voffA);
            PG8_WAIT_L(8); PG8_BAR; PG8_WAIT_L(0); PG8_MMA(0, 0, At, B0); PG8_BAR; PG8_SCHED;
            PG8_LDB(B1, 0, 1); PG8_STAGE(PG8_SB(0, 0), b2, voffB);
            PG8_BAR; PG8_WAIT_L(0); PG8_MMA(0, 1, At, B1); PG8_BAR;
            PG8_LDA(At, 0, 1); PG8_STAGE(PG8_SA(0, 0), a2, voffA);
            PG8_BAR; PG8_WAIT_L(0); PG8_MMA(1, 0, At, B0); PG8_BAR; PG8_SCHED;
            PG8_STAGE(PG8_SB(0, 1), b2 + hstep, voffB);
            PG8_WAIT_V(6); PG8_BAR; PG8_MMA(1, 1, At, B1); PG8_BAR;
            PG8_LDB(B0, 1, 0); PG8_SCHED; PG8_LDA(At, 1, 0); PG8_STAGE(PG8_SA(0, 1), a2 + hstep, voffA);
            PG8_WAIT_L(8); PG8_BAR; PG8_WAIT_L(0); PG8_MMA(0, 0, At, B0); PG8_BAR; PG8_SCHED;
            PG8_LDB(B1, 1, 1); PG8_STAGE(PG8_SB(1, 0), b3, voffB);
            PG8_BAR; PG8_WAIT_L(0); PG8_MMA(0, 1, At, B1); PG8_BAR;
            PG8_LDA(At, 1, 1); PG8_STAGE(PG8_SA(1, 0), a3, voffA);
            PG8_BAR; PG8_WAIT_L(0); PG8_MMA(1, 0, At, B0); PG8_BAR; PG8_SCHED;
            PG8_STAGE(PG8_SB(1, 1), b3 + hstep, voffB);
            PG8_WAIT_V(6); PG8_BAR; PG8_MMA(1, 1, At, B1); PG8_BAR;
            }
        }
        if constexpr (ALIGN_EPI) { if (wr == 0) PG8_BAR; }
        if constexpr (!Epi::AFTER_DRAIN) { E(acc, cur, wr, wc, fr, fq); S.done(cur); }
        if (!has_next) break;
#pragma unroll
        for (int a = 0; a < 2; ++a)
#pragma unroll
            for (int b = 0; b < 2; ++b)
#pragma unroll
                for (int m = 0; m < 4; ++m)
#pragma unroll
                    for (int n = 0; n < 2; ++n) acc[a][b][m][n] = (f32x4){0.f, 0.f, 0.f, 0.f};
        cur = nxt; cA = nA; cB = nB; ++ui;
        if constexpr (ALIGN_EPI) { if (wr == 1) PG8_BAR; }
    }
    PG8_WAIT_V(0);
    if constexpr (!ALIGN_EPI) { if (wr == 0) PG8_BAR; }
    PG8_BAR;
    if constexpr (Epi::AFTER_DRAIN) { E.fused(acc, cur, wr, wc, fr, fq, lds, wid, lane); S.done(cur); }
#undef PG8_SA
#undef PG8_SB
#undef PG8_STAGE
#undef PG8_LDA
#undef PG8_LDB
#undef PG8_MMA
#undef PG8_WAIT_V
#undef PG8_WAIT_L
#undef PG8_BAR
#undef PG8_SCHED
}
}

#define LAS __attribute__((address_space(3)))
typedef unsigned short bf16;
typedef pg8::f32x4 f32x4;
typedef pg8::u32x4 u32x4;
typedef pg8::bf16x8 bf16x8;
typedef unsigned u32x2 __attribute__((ext_vector_type(2)));
typedef float f32x2v __attribute__((ext_vector_type(2)));

constexpr int NB = 4, SEQ = 8192, D = 1024, M = NB * SEQ;
constexpr int NH = 4, DK = 256, DV = 512;
constexpr int NT1 = 24, NT2 = 20, NIN = (NT1 + NT2) * 256;
constexpr int NPHASE = 10;

constexpr size_t MiB = 1u << 20;
constexpr size_t WS_CTL = 0, CTL_BYTES = 1 * MiB;
constexpr size_t WS_MOD = 1 * MiB;
constexpr size_t WS_WIN = 2 * MiB;
constexpr size_t WS_WRET = 24 * MiB;
constexpr size_t WS_WCONV = 28 * MiB;
constexpr size_t WS_WOUT = 30 * MiB;
constexpr size_t WS_H = 32 * MiB;
constexpr size_t WS_Q = 96 * MiB;
constexpr size_t WS_K = 160 * MiB;
constexpr size_t WS_V = 224 * MiB;
constexpr size_t WS_ZR = 352 * MiB;
constexpr size_t WS_END = 480 * MiB;
constexpr int CW_BAR = 4096;

typedef float f32x2_t __attribute__((ext_vector_type(2)));
typedef __bf16 bf16x2_t __attribute__((ext_vector_type(2)));
__device__ __forceinline__ unsigned cvt_pk(float lo, float hi) { const f32x2_t v = {lo, hi}; const bf16x2_t b = __builtin_convertvector(v, bf16x2_t); return __builtin_bit_cast(unsigned, b); }
__device__ __forceinline__ float bf_lo(unsigned u) { return __uint_as_float(u << 16); }
__device__ __forceinline__ float bf_hi(unsigned u) { return __uint_as_float(u & 0xffff0000u); }
__device__ __forceinline__ float fsigmoid(float x) { return __builtin_amdgcn_rcpf(1.0f + __builtin_amdgcn_exp2f(x * -1.4426950408889634f)); }
__device__ __forceinline__ float fsilu(float x) { return x * fsigmoid(x); }

struct EpiProj1 {
    static constexpr bool PERM = true, AFTER_DRAIN = false;
    bf16* Q; bf16* K; bf16* V; bf16* ZR; const int* pos;
    __device__ __forceinline__ void operator()(const f32x4 (&acc)[2][2][4][2], const pg8::Unit& u, int wr, int wc, int fr, int fq) const {
        const int row0 = u.pm * 256 + wr * 64 + fr, cb = wc * 32 + 8 * fq, pn = u.pn;
        if (pn < 8) {
            bf16* base = (pn < 4 ? Q : K) + (pn & 3) * 256 + cb;
            const float sc = pn < 4 ? 1.0f : 0.0625f;
            float invf[8];
#pragma unroll
            for (int i = 0; i < 8; ++i) invf[i] = exp2f((float)(cb + i) * (-13.287712379549449f / 128.0f));
#pragma unroll
            for (int ai = 0; ai < 2; ++ai)
#pragma unroll
                for (int m = 0; m < 4; ++m) {
                    const int row = row0 + ai * 128 + m * 16;
                    const float p = (float)pos[row];
                    float o1[8], o2[8];
#pragma unroll
                    for (int n = 0; n < 2; ++n)
#pragma unroll
                        for (int j = 0; j < 4; ++j) {
                            const float ang = p * invf[n * 4 + j];
                            const float nn = rintf(ang * 0.15915494309189535f);
                            float r = fmaf(-nn, 6.2831854820251465f, ang);
                            r = fmaf(-nn, -1.7484555e-7f, r);
                            const float rv = r * 0.15915494309189535f;
                            const float s = __builtin_amdgcn_sinf(rv), c = __builtin_amdgcn_cosf(rv);
                            const float t1 = acc[ai][0][m][n][j], t2 = acc[ai][1][m][n][j];
                            o1[n * 4 + j] = (t1 * c - t2 * s) * sc; o2[n * 4 + j] = (t1 * s + t2 * c) * sc;
                        }
                    bf16* rp = base + (size_t)row * 1024;
                    u32x4 w1, w2;
                    w1.x = cvt_pk(o1[0], o1[1]); w1.y = cvt_pk(o1[2], o1[3]); w1.z = cvt_pk(o1[4], o1[5]); w1.w = cvt_pk(o1[6], o1[7]);
                    w2.x = cvt_pk(o2[0], o2[1]); w2.y = cvt_pk(o2[2], o2[3]); w2.z = cvt_pk(o2[4], o2[5]); w2.w = cvt_pk(o2[6], o2[7]);
                    *(u32x4*)rp = w1; *(u32x4*)(rp + 128) = w2;
                }
        } else {
            const bool act = pn >= 16;
            bf16* base = (act ? ZR + (pn - 16) * 256 : V + (pn - 8) * 256) + cb;
#pragma unroll
            for (int ai = 0; ai < 2; ++ai)
#pragma unroll
                for (int m = 0; m < 4; ++m) {
                    bf16* rp = base + (size_t)(row0 + ai * 128 + m * 16) * 2048;
#pragma unroll
                    for (int bj = 0; bj < 2; ++bj) {
                        f32x4 v0 = acc[ai][bj][m][0], v1 = acc[ai][bj][m][1];
                        if (act) {
#pragma unroll
                            for (int j = 0; j < 4; ++j) { v0[j] = fsilu(v0[j]); v1[j] = fsilu(v1[j]); }
                        }
                        u32x4 w; w.x = cvt_pk(v0[0], v0[1]); w.y = cvt_pk(v0[2], v0[3]); w.z = cvt_pk(v1[0], v1[1]); w.w = cvt_pk(v1[2], v1[3]);
                        *(u32x4*)(rp + bj * 128) = w;
                    }
                }
        }
    }
};
struct EpiProj2 {
    static constexpr bool PERM = true, AFTER_DRAIN = false;
    bf16* A; bf16* ZC; bf16* SGA; bf16* SGB;
    __device__ __forceinline__ void operator()(const f32x4 (&acc)[2][2][4][2], const pg8::Unit& u, int wr, int wc, int fr, int fq) const {
        const int row0 = u.pm * 256 + wr * 64 + fr, cb = wc * 32 + 8 * fq, pn = u.pn;
        if (pn < 8) {
            bf16* base = A + pn * 128 + cb;
#pragma unroll
            for (int ai = 0; ai < 2; ++ai)
#pragma unroll
                for (int m = 0; m < 4; ++m) {
                    f32x4 v0 = acc[ai][0][m][0], v1 = acc[ai][0][m][1]; const f32x4 g0 = acc[ai][1][m][0], g1 = acc[ai][1][m][1];
#pragma unroll
                    for (int j = 0; j < 4; ++j) { v0[j] *= fsigmoid(g0[j]); v1[j] *= fsigmoid(g1[j]); }
                    u32x4 w; w.x = cvt_pk(v0[0], v0[1]); w.y = cvt_pk(v0[2], v0[3]); w.z = cvt_pk(v1[0], v1[1]); w.w = cvt_pk(v1[2], v1[3]);
                    *(u32x4*)(base + (size_t)(row0 + ai * 128 + m * 16) * 1024) = w;
                }
        } else {
            const bool isz = pn < 12;
            bf16* base = (isz ? ZC + (pn - 8) * 256 : (pn < 16 ? SGA + (pn - 12) * 256 : SGB + (pn - 16) * 256)) + cb;
#pragma unroll
            for (int ai = 0; ai < 2; ++ai)
#pragma unroll
                for (int m = 0; m < 4; ++m) {
                    bf16* rp = base + (size_t)(row0 + ai * 128 + m * 16) * 1024;
#pragma unroll
                    for (int bj = 0; bj < 2; ++bj) {
                        f32x4 v0 = acc[ai][bj][m][0], v1 = acc[ai][bj][m][1];
#pragma unroll
                        for (int j = 0; j < 4; ++j) { const float s0 = fsigmoid(v0[j]), s1 = fsigmoid(v1[j]); v0[j] = isz ? v0[j] * s0 : s0; v1[j] = isz ? v1[j] * s1 : s1; }
                        u32x4 w; w.x = cvt_pk(v0[0], v0[1]); w.y = cvt_pk(v0[2], v0[3]); w.z = cvt_pk(v1[0], v1[1]); w.w = cvt_pk(v1[2], v1[3]);
                        *(u32x4*)(rp + bj * 128) = w;
                    }
                }
        }
    }
};
struct EpiYa {
    static constexpr bool PERM = true, AFTER_DRAIN = false;
    float* TA; const bf16* SGA;
    __device__ __forceinline__ void operator()(const f32x4 (&acc)[2][2][4][2], const pg8::Unit& u, int wr, int wc, int fr, int fq) const {
        const int row0 = u.pm * 256 + wr * 64 + fr, col0 = u.pn * 256 + wc * 32 + 8 * fq;
#pragma unroll
        for (int ai = 0; ai < 2; ++ai)
#pragma unroll
            for (int m = 0; m < 4; ++m) {
                const size_t ro = (size_t)(row0 + ai * 128 + m * 16) * 1024 + col0;
#pragma unroll
                for (int bj = 0; bj < 2; ++bj) {
                    const u32x4 g = *(const u32x4*)(SGA + ro + bj * 128);
                    f32x4 v0 = acc[ai][bj][m][0], v1 = acc[ai][bj][m][1];
                    v0[0] *= bf_lo(g.x); v0[1] *= bf_hi(g.x); v0[2] *= bf_lo(g.y); v0[3] *= bf_hi(g.y);
                    v1[0] *= bf_lo(g.z); v1[1] *= bf_hi(g.z); v1[2] *= bf_lo(g.w); v1[3] *= bf_hi(g.w);
                    *(f32x4*)(TA + ro + bj * 128) = v0; *(f32x4*)(TA + ro + bj * 128 + 4) = v1;
                }
            }
    }
};
struct EpiYb {
    static constexpr bool PERM = true, AFTER_DRAIN = false;
    const float* TA; const bf16* SGB; bf16* MG;
    __device__ __forceinline__ void operator()(const f32x4 (&acc)[2][2][4][2], const pg8::Unit& u, int wr, int wc, int fr, int fq) const {
        const int row0 = u.pm * 256 + wr * 64 + fr, col0 = u.pn * 256 + wc * 32 + 8 * fq;
#pragma unroll
        for (int ai = 0; ai < 2; ++ai)
#pragma unroll
            for (int m = 0; m < 4; ++m) {
                const size_t ro = (size_t)(row0 + ai * 128 + m * 16) * 1024 + col0;
#pragma unroll
                for (int bj = 0; bj < 2; ++bj) {
                    const u32x4 g = *(const u32x4*)(SGB + ro + bj * 128);
                    const f32x4 t0 = *(const f32x4*)(TA + ro + bj * 128), t1 = *(const f32x4*)(TA + ro + bj * 128 + 4);
                    f32x4 v0 = acc[ai][bj][m][0], v1 = acc[ai][bj][m][1];
                    v0[0] = t0[0] + v0[0] * bf_lo(g.x); v0[1] = t0[1] + v0[1] * bf_hi(g.x); v0[2] = t0[2] + v0[2] * bf_lo(g.y); v0[3] = t0[3] + v0[3] * bf_hi(g.y);
                    v1[0] = t1[0] + v1[0] * bf_lo(g.z); v1[1] = t1[1] + v1[1] * bf_hi(g.z); v1[2] = t1[2] + v1[2] * bf_lo(g.w); v1[3] = t1[3] + v1[3] * bf_hi(g.w);
                    u32x4 w; w.x = cvt_pk(v0[0], v0[1]); w.y = cvt_pk(v0[2], v0[3]); w.z = cvt_pk(v1[0], v1[1]); w.w = cvt_pk(v1[2], v1[3]);
                    *(u32x4*)(MG + ro + bj * 128) = w;
                }
            }
    }
};
struct EpiY {
    static constexpr bool PERM = true, AFTER_DRAIN = false;
    float* Y;
    __device__ __forceinline__ void operator()(const f32x4 (&acc)[2][2][4][2], const pg8::Unit& u, int wr, int wc, int fr, int fq) const {
        const int row0 = u.pm * 256 + wr * 64 + fr, col0 = u.pn * 256 + wc * 32 + 8 * fq;
#pragma unroll
        for (int ai = 0; ai < 2; ++ai)
#pragma unroll
            for (int m = 0; m < 4; ++m) {
                float* rp = Y + (size_t)(row0 + ai * 128 + m * 16) * 1024 + col0;
#pragma unroll
                for (int bj = 0; bj < 2; ++bj) { *(f32x4*)(rp + bj * 128) = acc[ai][bj][m][0]; *(f32x4*)(rp + bj * 128 + 4) = acc[ai][bj][m][1]; }
            }
    }
};
#define XB_TMO      128
#define XB_XCNT(j)  (256  + 64 * (j))
#define XB_XSUB(j)  (1280 + 64 * (j))
#define XB_XGEN(j)  (2304 + 64 * (j))
#define XB_TOP      3328
#define XB_TOPGEN   3392
#define XCD_BAR_WORDS 3456
#define XB_SPIN_CAP (1u << 18)

__device__ __forceinline__ unsigned xb_ld(unsigned* p)              { return __hip_atomic_load(p, __ATOMIC_RELAXED, __HIP_MEMORY_SCOPE_AGENT); }
__device__ __forceinline__ unsigned xb_add(unsigned* p, unsigned v) { return __hip_atomic_fetch_add(p, v, __ATOMIC_RELAXED, __HIP_MEMORY_SCOPE_AGENT); }
__device__ __forceinline__ unsigned xb_xcc_id() { return (unsigned)__builtin_amdgcn_s_getreg((3 << 11) | 20) & 0xFu; }
#define XB_SPIN(cond, bar) do { unsigned _sp = 0; while (cond) { __builtin_amdgcn_s_sleep(1); \
    if ((++_sp & 255u) == 0u) { if (xb_ld(&(bar)[XB_TMO])) break; if (_sp > XB_SPIN_CAP) { atomicAdd(&(bar)[XB_TMO], 1u); break; } } } } while (0)

struct XcdBarrier {
    unsigned* bar; unsigned x;
    volatile LAS unsigned* st;
};

__device__ __forceinline__ XcdBarrier xcd_barrier_post(unsigned* bar, volatile LAS unsigned* st) {
    XcdBarrier b; b.bar = bar; b.x = xb_xcc_id(); b.st = st;
    if (threadIdx.x == 0) (void)xb_add(&bar[XB_XCNT(b.x)], 1u);
    return b;
}
__device__ __forceinline__ void xcd_barrier_complete(unsigned* bar, unsigned x, unsigned& nloc, unsigned& nx) {
    const unsigned G = gridDim.x * gridDim.y * gridDim.z;
    unsigned sum, cnt, mine, sp = 0u;
    for (;;) {
        sum = 0u; cnt = 0u; mine = 0u;
#pragma unroll
        for (unsigned j = 0; j < 16; ++j) { const unsigned c = xb_ld(&bar[XB_XCNT(j)]); sum += c; cnt += (c > 0u) ? 1u : 0u; mine = (j == x) ? c : mine; }
        if (sum == G) break;
        __builtin_amdgcn_s_sleep(1);
        if ((++sp & 255u) == 0u) { if (xb_ld(&bar[XB_TMO])) break; if (sp > XB_SPIN_CAP) { atomicAdd(&bar[XB_TMO], 1u); break; } }
    }
    nloc = mine > 0u ? mine : 1u; nx = cnt > 0u ? cnt : 1u;
}

__device__ __forceinline__ void xcd_barrier(const XcdBarrier& b) {
    asm volatile("s_waitcnt vmcnt(0)" ::: "memory");
    __syncthreads();
    if (threadIdx.x == 0) {
        unsigned* bar = b.bar;
        __builtin_amdgcn_s_waitcnt(0);
        unsigned nloc = b.st[0], nx = b.st[1];
        if (nloc == 0u) { xcd_barrier_complete(bar, b.x, nloc, nx); b.st[0] = nloc; b.st[1] = nx; }
        const unsigned old = xb_add(&bar[XB_XSUB(b.x)], 1u);
        const unsigned gen = old / nloc;
        if (old + 1u == (gen + 1u) * nloc) {
            __builtin_amdgcn_fence(__ATOMIC_RELEASE, "agent");
            asm volatile("s_waitcnt vmcnt(0)" ::: "memory");
            const unsigned og = xb_add(&bar[XB_TOP], 1u);
            const unsigned tg = og / nx;
            if (og + 1u == (tg + 1u) * nx) xb_add(&bar[XB_TOPGEN], 1u);
            else XB_SPIN(xb_ld(&bar[XB_TOPGEN]) == tg, bar);
            __builtin_amdgcn_fence(__ATOMIC_ACQUIRE, "agent");
            xb_add(&bar[XB_XGEN(b.x)], 1u);
            asm volatile("s_waitcnt vmcnt(0)" ::: "memory");
        } else {
            XB_SPIN(xb_ld(&bar[XB_XGEN(b.x)]) == gen, bar);
            __builtin_amdgcn_fence(__ATOMIC_ACQUIRE, "agent");
            asm volatile("s_waitcnt vmcnt(0)" ::: "memory");
        }
    }
    __syncthreads();
}

constexpr int RING_BYTES = 131072;
constexpr int LDSCTL_OFF = RING_BYTES, MISC_OFF = LDSCTL_OFF + 320;
constexpr int LDS_BYTES = 147456;
struct Frame {
    LAS unsigned char* lds;
    volatile LAS unsigned* MISC;
    unsigned* ctl;
    int tid, lane, wave, vcu, G;
    const float *x, *c, *w_ada, *b_ada, *pre_g, *w_in, *conv_w, *conv_b, *ln_g, *ln_b, *w_ret, *w_conv, *w_out, *post_g;
    const int* pos;
    float* out; float* mod;
    bf16 *WIN, *WRET, *WCONV, *WOUT, *H, *Q, *K, *V, *ZR, *SGA, *SGB;
    float* F32S;
};
__device__ __forceinline__ float wave_sum(float v) {
#pragma unroll
    for (int o = 1; o < 64; o <<= 1) v += __shfl_xor(v, o);
    return v;
}
#define LDS_WAIT() asm volatile("s_waitcnt lgkmcnt(0)" ::: "memory")
#define RAW_BAR() do { asm volatile("s_waitcnt lgkmcnt(0)" ::: "memory"); __builtin_amdgcn_s_barrier(); asm volatile("" ::: "memory"); } while (0)

__device__ __forceinline__ void transpose_item(const float* W, int K, int N, bf16* WT, int dst_row0, int src_col0, int k0, LAS float* scr, int lane) {
#pragma unroll 8
    for (int i = 0; i < 32; ++i) { const int kk = 2 * i + (lane >> 5); scr[kk * 33 + (lane & 31)] = W[(size_t)(k0 + kk) * N + src_col0 + (lane & 31)]; }
    LDS_WAIT(); asm volatile("" ::: "memory");
    const int c = lane & 7;
#pragma unroll
    for (int j = 0; j < 4; ++j) { const int n = (lane >> 3) + 8 * j; const LAS float* s = scr + (8 * c) * 33 + n;
        u32x4 o; o.x = cvt_pk(s[0 * 33], s[1 * 33]); o.y = cvt_pk(s[2 * 33], s[3 * 33]); o.z = cvt_pk(s[4 * 33], s[5 * 33]); o.w = cvt_pk(s[6 * 33], s[7 * 33]);
        *(u32x4*)(WT + (size_t)(dst_row0 + n) * K + k0 + 8 * c) = o; }
    LDS_WAIT(); asm volatile("" ::: "memory");
}
__device__ __forceinline__ int win_src_col(int n0) {
    if (n0 >= 6144 && n0 < 8192) { const int t = (n0 - 6144) >> 8, wi = (n0 - 6144) & 255; return wi < 128 ? 6144 + 128 * t + wi : 7168 + 128 * t + (wi - 128); }
    return n0;
}
__device__ __forceinline__ void phase0(Frame& F) {
    LAS float* red = (LAS float*)F.lds;
    for (int cg = blockIdx.x; cg < 48; cg += F.G) {
        const int col = cg * 64 + F.lane; float a0 = 0.f, a1 = 0.f, a2 = 0.f, a3 = 0.f;
        const int kb = F.wave * 128;
#pragma unroll 16
        for (int k = 0; k < 128; ++k) { const float wv = F.w_ada[(size_t)(kb + k) * 3072 + col];
            a0 = fmaf(F.c[kb + k], wv, a0); a1 = fmaf(F.c[1024 + kb + k], wv, a1); a2 = fmaf(F.c[2048 + kb + k], wv, a2); a3 = fmaf(F.c[3072 + kb + k], wv, a3); }
        red[(F.wave * 4 + 0) * 64 + F.lane] = a0; red[(F.wave * 4 + 1) * 64 + F.lane] = a1; red[(F.wave * 4 + 2) * 64 + F.lane] = a2; red[(F.wave * 4 + 3) * 64 + F.lane] = a3;
        __syncthreads();
        if (F.wave < 4) { float s = 0.f;
#pragma unroll
            for (int w = 0; w < 8; ++w) s += red[(w * 4 + F.wave) * 64 + F.lane];
            F.mod[F.wave * 3072 + col] = s + F.b_ada[col]; }
        __syncthreads();
    }
    LAS float* scr = (LAS float*)(F.lds + F.wave * 8448);
    const int gw = F.vcu * 8 + F.wave, NGW = F.G * 8;
    constexpr int I_IN = 16 * 352, I_RET = 32 * 32, I_CV = 16 * 32, I_OUT = 16 * 32;
    for (int it = gw; it < I_IN + I_RET + I_CV + I_OUT; it += NGW) {
        int r = it;
        if (r < I_IN) { const int kb = r / 352, nb = r % 352; transpose_item(F.w_in, 1024, NIN, F.WIN, nb * 32, win_src_col(nb * 32), kb * 64, scr, F.lane); continue; } r -= I_IN;
        if (r < I_RET) { const int kb = r >> 5, nb = r & 31; transpose_item(F.w_ret, 2048, 1024, F.WRET, nb * 32, nb * 32, kb * 64, scr, F.lane); continue; } r -= I_RET;
        if (r < I_CV) { const int kb = r >> 5, nb = r & 31; transpose_item(F.w_conv, 1024, 1024, F.WCONV, nb * 32, nb * 32, kb * 64, scr, F.lane); continue; } r -= I_CV;
        { const int kb = r >> 5, nb = r & 31; transpose_item(F.w_out, 1024, 1024, F.WOUT, nb * 32, nb * 32, kb * 64, scr, F.lane); }
    }
}
__device__ __forceinline__ void phase1(Frame& F) {
    const int gw = F.vcu * 8 + F.wave, NGW = F.G * 8;
    for (int rb = gw; rb < M / 16; rb += NGW) {
        const int b = (rb * 16) / SEQ;
        f32x4 ca[4], cs[4];
#pragma unroll
        for (int j = 0; j < 4; ++j) { const int col = 4 * F.lane + 256 * j;
            const f32x4 g = *(const f32x4*)(F.pre_g + col), sc = *(const f32x4*)(F.mod + b * 3072 + 1024 + col);
            ca[j] = g * (sc + 1.0f); cs[j] = *(const f32x4*)(F.mod + b * 3072 + col); }
        for (int r = 0; r < 16; r += 4) {
            const size_t m = (size_t)rb * 16 + r;
            f32x4 v[4][4]; float ss[4];
#pragma unroll
            for (int q = 0; q < 4; ++q) { const f32x4* xr = (const f32x4*)(F.x + (m + q) * D) + F.lane;
#pragma unroll
                for (int j = 0; j < 4; ++j) v[q][j] = xr[64 * j]; }
#pragma unroll
            for (int q = 0; q < 4; ++q) { float s = 0.f;
#pragma unroll
                for (int j = 0; j < 4; ++j) s += (v[q][j][0] * v[q][j][0] + v[q][j][1] * v[q][j][1]) + (v[q][j][2] * v[q][j][2] + v[q][j][3] * v[q][j][3]);
                ss[q] = s; }
#pragma unroll
            for (int q = 0; q < 4; ++q) ss[q] = wave_sum(ss[q]);
#pragma unroll
            for (int q = 0; q < 4; ++q) { const float rstd = rsqrtf(ss[q] * (1.0f / D) + 1e-6f);
                u32x2* o8 = (u32x2*)(F.H + (m + q) * D) + F.lane;
#pragma unroll
                for (int j = 0; j < 4; ++j) { const f32x4 y = v[q][j] * rstd * ca[j] + cs[j]; u32x2 w; w.x = cvt_pk(y[0], y[1]); w.y = cvt_pk(y[2], y[3]); o8[64 * j] = w; } }
        }
    }
}
constexpr int R_ROW = 528, R_PROW = 160, R_VROW = 272;
constexpr int R_QS = 0, R_KS = 64 * R_ROW, R_P = 2 * 64 * R_ROW, R_VZ = R_P + 64 * R_PROW, R_END = R_VZ + 64 * R_VROW;
static_assert(R_END <= RING_BYTES, "retention LDS map");
typedef short v4i16_t __attribute__((ext_vector_type(4)));
__device__ __forceinline__ bf16x8 ldfrag(const LAS unsigned char* p) { return *(const LAS bf16x8*)p; }
__device__ __forceinline__ v4i16_t ldtr(const LAS unsigned char* p) { return __builtin_amdgcn_ds_read_tr16_b64_v4i16((LAS v4i16_t*)p); }
__device__ __forceinline__ bf16x8 ldtr2(const LAS unsigned char* p, int step) {
    const v4i16_t t0 = ldtr(p), t1 = ldtr(p + step);
    bf16x8 f; f[0] = t0[0]; f[1] = t0[1]; f[2] = t0[2]; f[3] = t0[3]; f[4] = t1[0]; f[5] = t1[1]; f[6] = t1[2]; f[7] = t1[3]; return f;
}
__device__ __forceinline__ bf16x8 ld2x64(const LAS unsigned char* p0, const LAS unsigned char* p1) {
    const u32x2 a = *(const volatile LAS u32x2*)p0, b = *(const volatile LAS u32x2*)p1;
    u32x4 r; r.x = a.x; r.y = a.y; r.z = b.x; r.w = b.y; return __builtin_bit_cast(bf16x8, r);
}
__device__ __forceinline__ bf16x8 state_frag(const f32x4& s0, const f32x4& s1) {
    u32x4 r; r.x = cvt_pk(s0[0], s0[1]); r.y = cvt_pk(s0[2], s0[3]); r.z = cvt_pk(s1[0], s1[1]); r.w = cvt_pk(s1[2], s1[3]); return __builtin_bit_cast(bf16x8, r);
}
#define MFMA16(a, b, c) __builtin_amdgcn_mfma_f32_16x16x32_bf16(a, b, c, 0, 0, 0)
#define SCHED_FENCE() __builtin_amdgcn_sched_barrier(0)
#define RET_QS(AF_EXPR)                                                                                                      \
    {                                                                                                                         \
        bf16x8 qb[2][4];                                                                                                      \
        _Pragma("unroll") for (int ib = 0; ib < 4; ++ib) { const LAS unsigned char* qp = lds + R_QS + (ib * 16 + fr) * R_ROW + (4 * fq) * 2; qb[0][ib] = ld2x64(qp, qp + 32); } \
        _Pragma("unroll") for (int kq = 0; kq < 8; ++kq) {                                                                    \
            if (kq < 7) { _Pragma("unroll") for (int ib = 0; ib < 4; ++ib) { const LAS unsigned char* qp = lds + R_QS + (ib * 16 + fr) * R_ROW + (32 * (kq + 1) + 4 * fq) * 2; qb[(kq + 1) & 1][ib] = ld2x64(qp, qp + 32); } } \
            const bf16x8 af = (AF_EXPR);                                                                                      \
            SCHED_FENCE();                                                                                                    \
            _Pragma("unroll") for (int ib = 0; ib < 4; ++ib) aQ[ib] = MFMA16(af, qb[kq & 1][ib], aQ[ib]);                     \
            SCHED_FENCE();                                                                                                    \
        }                                                                                                                     \
    }
#define RSRC(p) __builtin_amdgcn_make_buffer_rsrc((void*)(p), (short)0, 0x7fffffff, 0x00020000)
#define BLD128(r, vo, so) __builtin_bit_cast(u32x4, __builtin_amdgcn_raw_buffer_load_b128(r, vo, so, 0))
#define BLD64(r, vo, so) __builtin_bit_cast(u32x2, __builtin_amdgcn_raw_buffer_load_b64(r, vo, so, 0))
#define BST64(v, r, vo, so) __builtin_amdgcn_raw_buffer_store_b64(__builtin_bit_cast(v2u_t, v), r, vo, so, 0)
typedef unsigned v2u_t __attribute__((__vector_size__(2 * sizeof(unsigned))));
__device__ __forceinline__ void ret_pass1(Frame& F) {
    LAS unsigned char* lds = F.lds;
    const int tid = F.tid, lane = F.lane, w = F.wave, fr = lane & 15, fq = lane >> 4;
    const int srow = tid >> 5, sc16 = tid & 31, vrow = tid >> 4, vc = tid & 15;
    const int sib = w >> 1, sil = sib * 16 + fr, jb0 = (w & 1) * 2, q4 = fr >> 2, p4 = fr & 3;
    float* Lw = (float*)F.out;
    for (int item = F.vcu; item < 256; item += F.G) {
        const int slice = item & 3, seg = (item >> 2) & 3, bh = item >> 4, b = bh >> 2, h = bh & 3;
        const float l2g = log2f(1.0f - exp2f(-5.0f - (float)h));
        const size_t tok0 = (size_t)b * SEQ + seg * 2048;
        const __amdgpu_buffer_rsrc_t Qg = RSRC(F.Q + tok0 * 1024 + h * 256), Kg = RSRC(F.K + tok0 * 1024 + h * 256), Vg = RSRC(F.V + tok0 * 2048 + h * 512 + slice * 128);
        unsigned oq[4], ov[2], oo4[4];
#pragma unroll
        for (int i = 0; i < 4; ++i) { oq[i] = (unsigned)((srow + 16 * i) * 2048 + sc16 * 16); oo4[i] = (unsigned)((i * 16 + fr) * 4096 + (16 * w + 4 * fq) * 2); }
#pragma unroll
        for (int i = 0; i < 2; ++i) ov[i] = (unsigned)((vrow + 32 * i) * 4096 + vc * 16);
        const float zeta0 = exp2f((float)(63 - vrow) * l2g), zeta1 = exp2f((float)(31 - vrow) * l2g), gC = exp2f(64.0f * l2g);
        float rs1[4], xi[4];
#pragma unroll
        for (int ib = 0; ib < 4; ++ib) { rs1[ib] = exp2f((float)(ib * 16 + fr - 63) * l2g); xi[ib] = exp2f((float)(ib * 16 + fr + 1) * l2g); }
        f32x4 S[16];
#pragma unroll
        for (int i = 0; i < 16; ++i) S[i] = (f32x4){0.f, 0.f, 0.f, 0.f};
        u32x4 pq[4], pk[4], pv[2]; u32x2 ost[4];
#pragma unroll
        for (int i = 0; i < 4; ++i) { pq[i] = BLD128(Qg, oq[i], 0); pk[i] = BLD128(Kg, oq[i], 0); ost[i] = (u32x2){0u, 0u}; }
#pragma unroll
        for (int i = 0; i < 2; ++i) pv[i] = BLD128(Vg, ov[i], 0);
        for (int n = 0; n < 32; ++n) {
#pragma unroll
            for (int i = 0; i < 4; ++i) { *(LAS u32x4*)(lds + R_QS + (srow + 16 * i) * R_ROW + sc16 * 16) = pq[i]; *(LAS u32x4*)(lds + R_KS + (srow + 16 * i) * R_ROW + sc16 * 16) = pk[i]; }
#pragma unroll
            for (int i = 0; i < 2; ++i) { const float z = i ? zeta1 : zeta0; u32x4 o;
                o.x = cvt_pk(bf_lo(pv[i].x) * z, bf_hi(pv[i].x) * z); o.y = cvt_pk(bf_lo(pv[i].y) * z, bf_hi(pv[i].y) * z); o.z = cvt_pk(bf_lo(pv[i].z) * z, bf_hi(pv[i].z) * z); o.w = cvt_pk(bf_lo(pv[i].w) * z, bf_hi(pv[i].w) * z);
                *(LAS u32x4*)(lds + R_VZ + (vrow + 32 * i) * R_VROW + vc * 16) = o; }
            RAW_BAR();
            if (n > 0) {
#pragma unroll
                for (int ib = 0; ib < 4; ++ib) BST64(ost[ib], Vg, oo4[ib], (n - 1) * (64 * 4096));
            }
            if (n + 1 < 32) {
#pragma unroll
                for (int i = 0; i < 4; ++i) { pq[i] = BLD128(Qg, oq[i], (n + 1) * (64 * 2048)); pk[i] = BLD128(Kg, oq[i], (n + 1) * (64 * 2048)); }
#pragma unroll
                for (int i = 0; i < 2; ++i) pv[i] = BLD128(Vg, ov[i], (n + 1) * (64 * 4096));
            }
            {
                f32x4 s0 = (f32x4){0.f, 0.f, 0.f, 0.f}, s1 = (f32x4){0.f, 0.f, 0.f, 0.f};
                const LAS unsigned char* qrow = lds + R_QS + sil * R_ROW + fq * 16;
                const LAS unsigned char* krow = lds + R_KS + (jb0 * 16 + fr) * R_ROW + fq * 16;
                bf16x8 sq[2], sk0[2], sk1[2];
#pragma unroll
                for (int ks = 0; ks < 2; ++ks) { sq[ks] = ldfrag(qrow + ks * 64); sk0[ks] = ldfrag(krow + ks * 64); sk1[ks] = ldfrag(krow + 16 * R_ROW + ks * 64); }
#pragma unroll
                for (int ks = 0; ks < 8; ++ks) {
                    SCHED_FENCE();
                    s0 = MFMA16(sk0[ks & 1], sq[ks & 1], s0); s1 = MFMA16(sk1[ks & 1], sq[ks & 1], s1);
                    SCHED_FENCE();
                    if (ks + 2 < 8) { sq[ks & 1] = ldfrag(qrow + (ks + 2) * 64); sk0[ks & 1] = ldfrag(krow + (ks + 2) * 64); sk1[ks & 1] = ldfrag(krow + 16 * R_ROW + (ks + 2) * 64); }
                }
                const int j0 = jb0 * 16 + 4 * fq;
#pragma unroll
                for (int x = 0; x < 4; ++x) { if (j0 + x > sil) s0[x] = 0.f; if (j0 + 16 + x > sil) s1[x] = 0.f; }
                u32x2 p0, p1; p0.x = cvt_pk(s0[0], s0[1]); p0.y = cvt_pk(s0[2], s0[3]); p1.x = cvt_pk(s1[0], s1[1]); p1.y = cvt_pk(s1[2], s1[3]);
                *(LAS u32x2*)(lds + R_P + sil * R_PROW + j0 * 2) = p0; *(LAS u32x2*)(lds + R_P + sil * R_PROW + (j0 + 16) * 2) = p1;
            }
            RAW_BAR();
            bf16x8 vzf[2];
#pragma unroll
            for (int ks = 0; ks < 2; ++ks) vzf[ks] = ldtr2(lds + R_VZ + (32 * ks + 8 * fq + q4) * R_VROW + 32 * w + 8 * p4, 4 * R_VROW);
            f32x4 aP[4], aQ[4];
#pragma unroll
            for (int ib = 0; ib < 4; ++ib) { aP[ib] = (f32x4){0.f, 0.f, 0.f, 0.f}; aQ[ib] = (f32x4){0.f, 0.f, 0.f, 0.f}; }
            {
                bf16x8 pf[2][4];
#pragma unroll
                for (int ib = 0; ib < 4; ++ib) pf[0][ib] = ldfrag(lds + R_P + (ib * 16 + fr) * R_PROW + fq * 16);
#pragma unroll
                for (int ks = 0; ks < 2; ++ks) {
                    if (ks == 0) {
#pragma unroll
                        for (int ib = 0; ib < 4; ++ib) pf[1][ib] = ldfrag(lds + R_P + (ib * 16 + fr) * R_PROW + fq * 16 + 64);
                    }
                    SCHED_FENCE();
#pragma unroll
                    for (int ib = 0; ib < 4; ++ib) aP[ib] = MFMA16(vzf[ks], pf[ks][ib], aP[ib]);
                    SCHED_FENCE();
                }
            }
            RET_QS(state_frag(S[2 * kq], S[2 * kq + 1]))
#pragma unroll
            for (int ib = 0; ib < 4; ++ib) { ost[ib].x = cvt_pk(rs1[ib] * aP[ib][0] + xi[ib] * aQ[ib][0], rs1[ib] * aP[ib][1] + xi[ib] * aQ[ib][1]); ost[ib].y = cvt_pk(rs1[ib] * aP[ib][2] + xi[ib] * aQ[ib][2], rs1[ib] * aP[ib][3] + xi[ib] * aQ[ib][3]); }
#pragma unroll
            for (int db = 0; db < 16; ++db) S[db] = S[db] * gC;
            {
                bf16x8 kf[2][4];
                const LAS unsigned char* kb = lds + R_KS + (8 * fq + q4) * R_ROW + 8 * p4;
#pragma unroll
                for (int j = 0; j < 4; ++j) kf[0][j] = ldtr2(kb + 32 * j, 4 * R_ROW);
#pragma unroll
                for (int g = 0; g < 8; ++g) {
                    if (g < 7) {
#pragma unroll
                        for (int j = 0; j < 4; ++j) kf[(g + 1) & 1][j] = ldtr2(kb + 32 * ((g + 1) >> 2) * R_ROW + 32 * (4 * ((g + 1) & 3) + j), 4 * R_ROW);
                    }
                    SCHED_FENCE();
#pragma unroll
                    for (int j = 0; j < 4; ++j) S[4 * (g & 3) + j] = MFMA16(kf[g & 1][j], vzf[g >> 2], S[4 * (g & 3) + j]);
                    SCHED_FENCE();
                }
            }
            RAW_BAR();
        }
#pragma unroll
        for (int ib = 0; ib < 4; ++ib) BST64(ost[ib], Vg, oo4[ib], 31 * (64 * 4096));
        float* Lp = Lw + ((size_t)(item * 8 + w) * 16) * 256 + lane * 4;
#pragma unroll
        for (int db = 0; db < 16; ++db) *(f32x4*)(Lp + db * 256) = S[db];
    }
}
__device__ __forceinline__ void ret_pass2(Frame& F) {
    LAS unsigned char* lds = F.lds;
    const int tid = F.tid, lane = F.lane, w = F.wave, fr = lane & 15, fq = lane >> 4;
    const int srow = tid >> 5, sc16 = tid & 31;
    const float* Lw = (const float*)F.out;
    for (int u = F.vcu; u < 768; u += F.G) {
        const int it3 = u >> 2, quarter = u & 3, slice = it3 & 3, sg = (it3 >> 2) % 3 + 1, bh = it3 / 12, b = bh >> 2, h = bh & 3;
        const float l2g = log2f(1.0f - exp2f(-5.0f - (float)h));
        const size_t tok0 = (size_t)b * SEQ + sg * 2048;
        const __amdgpu_buffer_rsrc_t Qg = RSRC(F.Q + tok0 * 1024 + h * 256), Vg = RSRC(F.V + tok0 * 2048 + h * 512 + slice * 128);
        unsigned oq[4], oo4[4];
#pragma unroll
        for (int i = 0; i < 4; ++i) { oq[i] = (unsigned)((srow + 16 * i) * 2048 + sc16 * 16); oo4[i] = (unsigned)((i * 16 + fr) * 4096 + (16 * w + 4 * fq) * 2); }
        f32x4 T[16];
#pragma unroll
        for (int i = 0; i < 16; ++i) T[i] = (f32x4){0.f, 0.f, 0.f, 0.f};
        for (int m = 0; m < sg; ++m) {
            const float coef = exp2f(2048.0f * (float)(sg - 1 - m) * l2g);
            const float* Lp = Lw + ((size_t)(((bh << 4) | (m << 2) | slice) * 8 + w) * 16) * 256 + lane * 4;
#pragma unroll
            for (int db = 0; db < 16; ++db) T[db] = T[db] + *(const f32x4*)(Lp + db * 256) * coef;
        }
        bf16x8 af8[8];
#pragma unroll
        for (int kq = 0; kq < 8; ++kq) af8[kq] = state_frag(T[2 * kq], T[2 * kq + 1]);
        const int n0 = quarter * 8;
        u32x4 pq[4]; u32x2 res[4];
#pragma unroll
        for (int i = 0; i < 4; ++i) { pq[i] = BLD128(Qg, oq[i], n0 * (64 * 2048)); res[i] = (u32x2){0u, 0u}; }
        for (int n = n0; n < n0 + 8; ++n) {
#pragma unroll
            for (int i = 0; i < 4; ++i) *(LAS u32x4*)(lds + R_QS + (srow + 16 * i) * R_ROW + sc16 * 16) = pq[i];
            RAW_BAR();
            if (n > n0) {
#pragma unroll
                for (int ib = 0; ib < 4; ++ib) BST64(res[ib], Vg, oo4[ib], (n - 1) * (64 * 4096));
            }
            if (n + 1 < n0 + 8) {
#pragma unroll
                for (int i = 0; i < 4; ++i) pq[i] = BLD128(Qg, oq[i], (n + 1) * (64 * 2048));
            }
            u32x2 oo[4];
#pragma unroll
            for (int ib = 0; ib < 4; ++ib) oo[ib] = BLD64(Vg, oo4[ib], n * (64 * 4096));
            f32x4 aQ[4];
#pragma unroll
            for (int ib = 0; ib < 4; ++ib) aQ[ib] = (f32x4){0.f, 0.f, 0.f, 0.f};
            RET_QS(af8[kq])
#pragma unroll
            for (int ib = 0; ib < 4; ++ib) { const float x = exp2f((float)(n * 64 + ib * 16 + fr + 1) * l2g);
                res[ib].x = cvt_pk(bf_lo(oo[ib].x) + x * aQ[ib][0], bf_hi(oo[ib].x) + x * aQ[ib][1]); res[ib].y = cvt_pk(bf_lo(oo[ib].y) + x * aQ[ib][2], bf_hi(oo[ib].y) + x * aQ[ib][3]); }
            RAW_BAR();
        }
#pragma unroll
        for (int ib = 0; ib < 4; ++ib) BST64(res[ib], Vg, oo4[ib], (n0 + 7) * (64 * 4096));
    }
}
__device__ __forceinline__ void gn_pass(Frame& F, bool dry) {
    const int gw = F.vcu * 8 + F.wave, NGW = F.G * 8;
    for (int t0 = gw * 2; t0 < M; t0 += NGW * 2) {
        u32x4 o[8], z[8];
#pragma unroll
        for (int q = 0; q < 8; ++q) { const size_t off = (size_t)(t0 + (q >> 2)) * 2048 + (q & 3) * 512 + F.lane * 8; o[q] = *(const u32x4*)(F.V + off); z[q] = *(const u32x4*)(F.ZR + off); }
        float v[8][8], s[8];
#pragma unroll
        for (int q = 0; q < 8; ++q) { v[q][0] = bf_lo(o[q].x); v[q][1] = bf_hi(o[q].x); v[q][2] = bf_lo(o[q].y); v[q][3] = bf_hi(o[q].y); v[q][4] = bf_lo(o[q].z); v[q][5] = bf_hi(o[q].z); v[q][6] = bf_lo(o[q].w); v[q][7] = bf_hi(o[q].w);
            s[q] = ((v[q][0] + v[q][1]) + (v[q][2] + v[q][3])) + ((v[q][4] + v[q][5]) + (v[q][6] + v[q][7])); }
#pragma unroll
        for (int q = 0; q < 8; ++q) s[q] = wave_sum(s[q]) * (1.0f / 512.0f);
#pragma unroll
        for (int q = 0; q < 8; ++q) { float a = 0.f;
#pragma unroll
            for (int i = 0; i < 8; ++i) { v[q][i] -= s[q]; a += v[q][i] * v[q][i]; }
            s[q] = a; }
#pragma unroll
        for (int q = 0; q < 8; ++q) s[q] = rsqrtf(wave_sum(s[q]) * (1.0f / 512.0f) + 1e-5f);
#pragma unroll
        for (int q = 0; q < 8; ++q) { const size_t off = (size_t)(t0 + (q >> 2)) * 2048 + (q & 3) * 512 + F.lane * 8; const float rs = s[q];
            u32x4 r; r.x = cvt_pk(v[q][0] * rs * bf_lo(z[q].x), v[q][1] * rs * bf_hi(z[q].x)); r.y = cvt_pk(v[q][2] * rs * bf_lo(z[q].y), v[q][3] * rs * bf_hi(z[q].y));
            r.z = cvt_pk(v[q][4] * rs * bf_lo(z[q].z), v[q][5] * rs * bf_hi(z[q].z)); r.w = cvt_pk(v[q][6] * rs * bf_lo(z[q].w), v[q][7] * rs * bf_hi(z[q].w));
            if (dry) *(u32x4*)(F.H + (off & (size_t)(32u * 1024u * 1024u - 1u))) = r; else *(u32x4*)(F.ZR + off) = r; }
    }
}
__device__ __forceinline__ void conv_pass(Frame& F) {
    LAS float* red = (LAS float*)F.lds;
    const int t = F.tid, c0 = 2 * t;
    float w0[31], w1[31];
#pragma unroll
    for (int k = 0; k < 31; ++k) { const f32x2v wv = *(const f32x2v*)(F.conv_w + k * 1024 + c0); w0[k] = wv.x; w1[k] = wv.y; }
    const f32x2v cb = *(const f32x2v*)(F.conv_b + c0), lg = *(const f32x2v*)(F.ln_g + c0), lb = *(const f32x2v*)(F.ln_b + c0);
    const bf16* A = F.Q;
    const bf16* ZC = F.K;
    for (int tile = F.vcu; tile < M / 128; tile += F.G) {
        const int tok0 = tile * 128, b = tok0 / SEQ, s0 = tok0 % SEQ;
        const bf16* Ab = A + (size_t)b * SEQ * 1024 + c0;
        float in0[38], in1[38];
#pragma unroll
        for (int i = 0; i < 38; ++i) { const int s = s0 - 30 + i; const int sc = s < 0 ? 0 : s;
            unsigned uu = *(const unsigned*)(Ab + (size_t)sc * 1024); if (s < 0) uu = 0u; in0[i] = bf_lo(uu); in1[i] = bf_hi(uu); }
        for (int gi = 0; gi < 16; ++gi) {
            const int sf = s0 + 8 * gi;
            unsigned nx[8], zz[8];
#pragma unroll
            for (int i = 0; i < 8; ++i) { const int sn = (gi < 15) ? sf + 8 + i : sf + i; nx[i] = *(const unsigned*)(Ab + (size_t)sn * 1024); }
#pragma unroll
            for (int j = 0; j < 8; ++j) zz[j] = *(const unsigned*)(ZC + (size_t)(tok0 + 8 * gi + j) * 1024 + c0);
            float a0[8], a1[8], ps[16];
#pragma unroll
            for (int j = 0; j < 8; ++j) { float x0 = cb.x, x1 = cb.y;
#pragma unroll
                for (int k = 0; k < 31; ++k) { x0 = fmaf(w0[k], in0[j + k], x0); x1 = fmaf(w1[k], in1[j + k], x1); }
                a0[j] = x0; a1[j] = x1; ps[j] = x0 + x1; ps[8 + j] = x0 * x0 + x1 * x1; }
#pragma unroll
            for (int j = 0; j < 16; ++j) ps[j] = wave_sum(ps[j]);
            if (F.lane < 16) { float v = ps[0];
#pragma unroll
                for (int j = 1; j < 16; ++j) v = (F.lane == j) ? ps[j] : v;
                red[F.wave * 16 + F.lane] = v; }
            RAW_BAR();
            if (t < 16) { float s = 0.f;
#pragma unroll
                for (int w = 0; w < 8; ++w) s += red[w * 16 + t];
                red[128 + t] = s; }
            RAW_BAR();
#pragma unroll
            for (int j = 0; j < 8; ++j) {
                const float mean = red[128 + j] * (1.0f / 1024.0f), var = red[136 + j] * (1.0f / 1024.0f) - mean * mean, rstd = rsqrtf(var + 1e-5f);
                const float y0 = (a0[j] - mean) * rstd * lg.x + lb.x, y1 = (a1[j] - mean) * rstd * lg.y + lb.y;
                unsigned* op = (unsigned*)(F.H + (size_t)(tok0 + 8 * gi + j) * 1024 + c0);
                *op = cvt_pk(fsilu(y0) * bf_lo(zz[j]), fsilu(y1) * bf_hi(zz[j]));
            }
#pragma unroll
            for (int i = 0; i < 30; ++i) { in0[i] = in0[i + 8]; in1[i] = in1[i + 8]; }
#pragma unroll
            for (int i = 0; i < 8; ++i) { in0[30 + i] = bf_lo(nx[i]); in1[30 + i] = bf_hi(nx[i]); }
        }
    }
    __syncthreads();
}
__device__ __forceinline__ void phase8(Frame& F) {
    const int gw = F.vcu * 8 + F.wave, NGW = F.G * 8;
    for (int rb = gw; rb < M / 16; rb += NGW) {
        const int b = (rb * 16) / SEQ;
        f32x4 cg[4];
#pragma unroll
        for (int j = 0; j < 4; ++j) { const int col = 4 * F.lane + 256 * j; cg[j] = *(const f32x4*)(F.post_g + col) * *(const f32x4*)(F.mod + b * 3072 + 2048 + col); }
        for (int r = 0; r < 16; r += 2) {
            const size_t m = (size_t)rb * 16 + r;
            f32x4 v[2][4], xv[2][4]; float ss[2];
#pragma unroll
            for (int q = 0; q < 2; ++q) { const f32x4* yr = (const f32x4*)(F.F32S + (m + q) * D) + F.lane; const f32x4* xr = (const f32x4*)(F.x + (m + q) * D) + F.lane;
#pragma unroll
                for (int j = 0; j < 4; ++j) { v[q][j] = yr[64 * j]; xv[q][j] = xr[64 * j]; } }
#pragma unroll
            for (int q = 0; q < 2; ++q) { float s = 0.f;
#pragma unroll
                for (int j = 0; j < 4; ++j) s += (v[q][j][0] * v[q][j][0] + v[q][j][1] * v[q][j][1]) + (v[q][j][2] * v[q][j][2] + v[q][j][3] * v[q][j][3]);
                ss[q] = s; }
#pragma unroll
            for (int q = 0; q < 2; ++q) ss[q] = wave_sum(ss[q]);
#pragma unroll
            for (int q = 0; q < 2; ++q) { const float rstd = rsqrtf(ss[q] * (1.0f / D) + 1e-6f);
                f32x4* orow = (f32x4*)(F.out + (m + q) * D) + F.lane;
#pragma unroll
                for (int j = 0; j < 4; ++j) orow[64 * j] = xv[q][j] + v[q][j] * rstd * cg[j]; }
        }
    }
}

struct Args { const float* in[15]; float* out; unsigned char* ws; int ph_lo, ph_hi; };
#ifndef MK_TWICE
#define MK_TWICE 0
#endif
#define REP(k) for (int rep_ = ((MK_TWICE >> (k)) & 1); rep_ >= 0; --rep_)
#define DRY ((bool)(rep_ > 0))
__global__ void __launch_bounds__(512, 2) mk_fwd(Args args) {
    extern __shared__ __attribute__((aligned(16))) unsigned char lds_raw[];
    Frame F;
    F.lds = (LAS unsigned char*)lds_raw;
    F.MISC = (volatile LAS unsigned*)(F.lds + MISC_OFF);
    F.tid = threadIdx.x; F.lane = F.tid & 63; F.wave = __builtin_amdgcn_readfirstlane(F.tid >> 6);
    F.G = gridDim.x; { const int bx = blockIdx.x; F.vcu = (F.G % 8 == 0) ? (bx % 8) * (F.G / 8) + bx / 8 : bx; }
    unsigned char* ws = args.ws;
    F.ctl = (unsigned*)(ws + WS_CTL);
    F.x = args.in[0]; F.c = args.in[1]; F.pos = (const int*)args.in[2]; F.w_ada = args.in[3]; F.b_ada = args.in[4]; F.pre_g = args.in[5]; F.w_in = args.in[6];
    F.conv_w = args.in[7]; F.conv_b = args.in[8]; F.ln_g = args.in[9]; F.ln_b = args.in[10]; F.w_ret = args.in[11]; F.w_conv = args.in[12]; F.w_out = args.in[13]; F.post_g = args.in[14];
    F.out = args.out; F.mod = (float*)(ws + WS_MOD);
    F.WIN = (bf16*)(ws + WS_WIN); F.WRET = (bf16*)(ws + WS_WRET); F.WCONV = (bf16*)(ws + WS_WCONV); F.WOUT = (bf16*)(ws + WS_WOUT);
    F.H = (bf16*)(ws + WS_H); F.Q = (bf16*)(ws + WS_Q); F.K = (bf16*)(ws + WS_K); F.V = (bf16*)(ws + WS_V); F.ZR = (bf16*)(ws + WS_ZR);
    F.SGA = (bf16*)args.out; F.SGB = (bf16*)args.out + (size_t)M * 1024; F.F32S = (float*)(ws + WS_V);
    for (int u = F.tid; u < (LDS_BYTES - LDSCTL_OFF) / 4; u += 512) ((LAS unsigned*)(F.lds + LDSCTL_OFF))[u] = 0u;
    __syncthreads();
    const int lo = args.ph_lo, hi = args.ph_hi;
    XcdBarrier bar; bar.bar = (unsigned*)(F.ctl + CW_BAR); bar.x = 0; bar.st = nullptr;
    if (hi - lo > 1) bar = xcd_barrier_post((unsigned*)(F.ctl + CW_BAR), F.MISC + 8);
#define IN(k) (lo <= (k) && (k) < hi)
#define SEAM(k) do { if (IN(k) && IN((k) + 1)) xcd_barrier(bar); } while (0)
    if (IN(0)) { phase0(F); } SEAM(0);
    if (IN(1)) { phase1(F); } SEAM(1);
    if (IN(2)) {
        pg8::Gemm g{F.H, F.WIN, M, NT1 * 256, 1024}; pg8::StaticOrder S; S.init(M, NT1 * 256, F.G, (int)blockIdx.x);
        EpiProj1 E{F.Q, F.K, F.V, F.ZR, F.pos};
        pg8::gemm_phase<EpiProj1, pg8::StaticOrder, true, true>(F.lds, g, S, E);
    } SEAM(2);
    if (IN(3)) { ret_pass1(F); } SEAM(3);
    if (IN(4)) { ret_pass2(F); } SEAM(4);
    if (IN(5)) {
        pg8::Gemm g{F.H, F.WIN + (size_t)NT1 * 256 * 1024, M, NT2 * 256, 1024}; pg8::StaticOrder S; S.init(M, NT2 * 256, F.G, (int)blockIdx.x);
        EpiProj2 E{F.Q, F.K, F.SGA, F.SGB};
        pg8::gemm_phase<EpiProj2, pg8::StaticOrder, true, true>(F.lds, g, S, E);
    } SEAM(5);
    if (IN(6)) { gn_pass(F, false); conv_pass(F); } SEAM(6);
    if (IN(7)) {
        pg8::StaticOrder S; S.init(M, 1024, F.G, (int)blockIdx.x);
        { pg8::Gemm g{F.ZR, F.WRET, M, 1024, 2048}; EpiYa E{F.F32S, F.SGA}; pg8::gemm_phase<EpiYa, pg8::StaticOrder, true, true>(F.lds, g, S, E); }
        { pg8::Gemm g{F.H, F.WCONV, M, 1024, 1024}; EpiYb E{F.F32S, F.SGB, F.Q}; pg8::gemm_phase<EpiYb, pg8::StaticOrder, true, true>(F.lds, g, S, E); }
    } SEAM(7);
    if (IN(8)) {
        pg8::Gemm g{F.Q, F.WOUT, M, 1024, 1024}; pg8::StaticOrder S; S.init(M, 1024, F.G, (int)blockIdx.x);
        EpiY E{F.F32S};
        pg8::gemm_phase<EpiY, pg8::StaticOrder, true, true>(F.lds, g, S, E);
    } SEAM(8);
    if (IN(9)) { phase8(F); }
#undef IN
#undef SEAM
}


__global__ void mk_dump(const unsigned char* ws, float* out, int which) {
    const size_t i = (size_t)blockIdx.x * blockDim.x + threadIdx.x;
    if (i >= (size_t)M * 1024) return;
    const size_t m = i >> 10, c = i & 1023;
    const bf16* Q = (const bf16*)(ws + WS_Q); const bf16* K = (const bf16*)(ws + WS_K); const bf16* V = (const bf16*)(ws + WS_V); const bf16* ZR = (const bf16*)(ws + WS_ZR); const bf16* H = (const bf16*)(ws + WS_H);
    float r = 0.f;
    auto f = [](bf16 v) { return __uint_as_float(((unsigned)v) << 16); };
    if (which == 0) r = f(H[i]);
    if (which == 1) r = f(Q[i]) + f(K[i]) + f(V[m * 2048 + c]) + f(V[m * 2048 + 1024 + c]) + f(ZR[m * 2048 + c]) + f(ZR[m * 2048 + 1024 + c]);
    if (which == 2) r = f(V[m * 2048 + c]) + f(V[m * 2048 + 1024 + c]);
    if (which == 3) r = f(Q[i]) + f(K[i]);
    if (which == 4) r = f(K[i]) + f(ZR[m * 2048 + c]) + f(ZR[m * 2048 + 1024 + c]);
    if (which == 5) r = f(H[i]);
    if (which == 6) r = ((const float*)(ws + WS_V))[i];
    out[i] = r;
}
#ifndef MK_SPLIT
#define MK_SPLIT 0
#endif
extern "C" void kernel_launch(void* const* d_in, const int* in_sizes, int n_in, void* d_out, int out_size, void* d_ws, size_t ws_size, hipStream_t stream) {
    static int grid = 0;
    if (grid == 0) {
        if (n_in != 15 || in_sizes[0] != M * D || out_size != M * D || ws_size < WS_END) { fprintf(stderr, "kernel_launch: unexpected shapes (n_in %d, in0 %d, out %d, ws %zu)\n", n_in, n_in > 0 ? in_sizes[0] : -1, out_size, ws_size); grid = -1; return; }
        int dev = 0, cus = 0;
        if (hipGetDevice(&dev) != hipSuccess || hipDeviceGetAttribute(&cus, hipDeviceAttributeMultiprocessorCount, dev) != hipSuccess) { grid = -1; return; }
        if (hipFuncSetAttribute((const void*)mk_fwd, hipFuncAttributeMaxDynamicSharedMemorySize, LDS_BYTES) != hipSuccess) { fprintf(stderr, "kernel_launch: hipFuncSetAttribute failed\n"); grid = -1; return; }
        grid = cus;
    }
    if (grid < 0) return;
    (void)hipMemsetAsync((char*)d_ws + WS_CTL, 0, CTL_BYTES, stream);
    Args a{};
    for (int i = 0; i < 15; ++i) a.in[i] = (const float*)d_in[i];
    a.out = (float*)d_out; a.ws = (unsigned char*)d_ws;
#if MK_SPLIT
#ifdef MK_DUMP_AFTER
    for (int p = 0; p <= MK_DUMP_AFTER; ++p) { a.ph_lo = p; a.ph_hi = p + 1; hipLaunchKernelGGL(mk_fwd, dim3(grid), dim3(512), LDS_BYTES, stream, a); }
    hipLaunchKernelGGL(mk_dump, dim3(M * 1024 / 256), dim3(256), 0, stream, (const unsigned char*)d_ws, (float*)d_out, MK_DUMP_WHICH);
#else
    for (int p = 0; p < NPHASE; ++p) { a.ph_lo = p; a.ph_hi = p + 1; hipLaunchKernelGGL(mk_fwd, dim3(grid), dim3(512), LDS_BYTES, stream, a); }
#endif
#else
#ifdef MK_PRE_LO
    a.ph_lo = MK_PRE_LO; a.ph_hi = MK_PRE_HI; hipLaunchKernelGGL(mk_fwd, dim3(grid), dim3(512), LDS_BYTES, stream, a);
#endif
    a.ph_lo = 0; a.ph_hi = NPHASE; hipLaunchKernelGGL(mk_fwd, dim3(grid), dim3(512), LDS_BYTES, stream, a);
#ifdef MK_EXTRA_LO
    a.ph_lo = MK_EXTRA_LO; a.ph_hi = MK_EXTRA_HI; hipLaunchKernelGGL(mk_fwd, dim3(grid), dim3(512), LDS_BYTES, stream, a);
#endif
#endif
}
```

```cpp
#include <hip/hip_runtime.h>
#include <cstdio>
#include <cstdint>
namespace pg8 {
#define PG8_LAS __attribute__((address_space(3)))
typedef unsigned short bf16_t;
typedef short bf16x8 __attribute__((ext_vector_type(8)));
typedef float f32x4 __attribute__((ext_vector_type(4)));
typedef unsigned u32x4 __attribute__((ext_vector_type(4)));
constexpr int BM = 256, BK = 64, HALF = 128, HTB = HALF * BK * 2  , STAGE_BYTES = 8 * HTB, NXCD = 8, WGM = 8;

__host__ __device__ __forceinline__ int lds_byte(int r, int c) { const int st = (r >> 4) * 2 + (c >> 5), rr = r & 15, cc = c & 31, ob = rr * 64 + cc * 2; return st * 1024 + (ob ^ (((ob >> 9) & 1) << 5)); }
__host__ __device__ __forceinline__ void stage_rc(int b, int& R, int& C) { const int st = b / 1024, sb = b % 1024, swz = sb ^ (((sb >> 9) & 1) << 5); R = (st >> 1) * 16 + swz / 64; C = (st & 1) * 32 + (swz % 64) / 2; }
__host__ __device__ __forceinline__ int perm32(int rho) { const int n = rho >> 4, i = rho & 15; return 8 * (i >> 2) + 4 * n + (i & 3); }

struct Unit { int pm, pn; };
struct Gemm { const bf16_t* A; const bf16_t* Bt; int M, N, K; };

struct StaticOrder {
    int nM, nN, nwg, G, c;
    __host__ __device__ void init(int M, int N, int G_, int c_) { nM = M / BM; nN = N / BM; nwg = nM * nN; G = G_; c = c_; }
    __host__ __device__ bool next(int i, Unit& u) const {
        const long L = (long)i * G + c; if (L >= nwg) return false;
        int wgid = (int)L; { const int q = nwg / NXCD, r = nwg % NXCD, xcd = wgid % NXCD, off = wgid / NXCD; wgid = (xcd < r ? xcd * (q + 1) : r * (q + 1) + (xcd - r) * q) + off; }
        const int nig = WGM * nN, gid = wgid / nig, fm = gid * WGM, gsz = (nM - fm) < WGM ? (nM - fm) : WGM;
        u.pm = fm + ((wgid % nig) % gsz); u.pn = (wgid % nig) / gsz; return true;
    }
    __device__ __forceinline__ void a_ready(const Unit&) const {}
    __device__ __forceinline__ void done(const Unit&) const {}
};
__device__ __forceinline__ unsigned cvt_pk_bf16(float lo, float hi) { unsigned r; asm volatile("v_cvt_pk_bf16_f32 %0, %1, %2" : "=v"(r) : "v"(lo), "v"(hi)); return r; }
template <class Epi, class Sched, bool ALIGN_EPI = false, bool SP2 = false>
__device__ __forceinline__ void gemm_phase(PG8_LAS unsigned char* lds, const Gemm g, const Sched& S, const Epi& E) {
    const int tid = threadIdx.x, wid = __builtin_amdgcn_readfirstlane(tid >> 6), lane = tid & 63, wr = wid >> 2, wc = wid & 3, fr = lane & 15, fq = lane >> 4;
    const int K = g.K, nt = K / BK;
    unsigned voffA[2], voffB[2];
#pragma unroll
    for (int i = 0; i < 2; ++i) { int R, C; stage_rc(tid * 16 + i * 8192, R, C); const int Rb = Epi::PERM ? ((R & ~31) + perm32(R & 31)) : R;
        voffA[i] = (unsigned)(R * K + C) * 2u; voffB[i] = (unsigned)(Rb * K + C) * 2u; }
    const size_t kstep = (size_t)(BK * 2);
    const size_t hstep = (size_t)HALF * K * 2;
    const size_t tstep = 2 * hstep;
    const unsigned ldsw = (unsigned)wid * 1024u;
    const int aoff = lds_byte(wr * 64 + fr, fq * 8), boff = lds_byte(wc * 32 + fr, fq * 8);
#define PG8_SA(b, h) (((b) * 2 + (h)) * HTB)
#define PG8_SB(b, h) ((4 + (b) * 2 + (h)) * HTB)
#define PG8_STAGE(bufoff, gbase, voff) do { _Pragma("unroll") for (int _i = 0; _i < 2; ++_i) \
        __builtin_amdgcn_global_load_lds((const unsigned*)((const char*)(gbase) + (voff)[_i]), (PG8_LAS unsigned*)(lds + (bufoff) + ldsw + _i * 8192), 16, 0, 0); } while (0)
#define PG8_LDA(dst, b, h) do { _Pragma("unroll") for (int m = 0; m < 4; ++m) _Pragma("unroll") for (int k = 0; k < 2; ++k) dst[m][k] = *(const PG8_LAS bf16x8*)(lds + PG8_SA(b, h) + aoff + m * 2048 + k * 1024); } while (0)
#define PG8_LDB(dst, b, h) do { _Pragma("unroll") for (int n = 0; n < 2; ++n) _Pragma("unroll") for (int k = 0; k < 2; ++k) dst[n][k] = *(const PG8_LAS bf16x8*)(lds + PG8_SB(b, h) + boff + n * 2048 + k * 1024); } while (0)
#define PG8_MMA(ai, bj, At, Bt) do { __builtin_amdgcn_s_setprio(1); _Pragma("unroll") for (int m = 0; m < 4; ++m) _Pragma("unroll") for (int n = 0; n < 2; ++n) _Pragma("unroll") for (int k = 0; k < 2; ++k) \
        acc[ai][bj][m][n] = __builtin_amdgcn_mfma_f32_16x16x32_bf16(Bt[n][k], At[m][k], acc[ai][bj][m][n], 0, 0, 0); __builtin_amdgcn_s_setprio(0); } while (0)
#define PG8_WAIT_V(n) asm volatile("s_waitcnt vmcnt(" #n ")" ::: "memory")
#define PG8_WAIT_L(n) asm volatile("s_waitcnt lgkmcnt(" #n ")" ::: "memory")
#define PG8_BAR __builtin_amdgcn_s_barrier()
#define PG8_SCHED __builtin_amdgcn_sched_barrier(0)
    Unit cur, nxt; int ui = 0;
    if (!S.next(0, cur)) return;
    f32x4 acc[2][2][4][2];
#pragma unroll
    for (int a = 0; a < 2; ++a)
#pragma unroll
        for (int b = 0; b < 2; ++b)
#pragma unroll
            for (int m = 0; m < 4; ++m)
#pragma unroll
                for (int n = 0; n < 2; ++n) acc[a][b][m][n] = (f32x4){0.f, 0.f, 0.f, 0.f};
    bf16x8 At[4][2], B0[2][2], B1[2][2];
    const char* cA = (const char*)g.A + (size_t)cur.pm * tstep; const char* cB = (const char*)g.Bt + (size_t)cur.pn * tstep;
    S.a_ready(cur);
    if constexpr (SP2) {
        PG8_STAGE(PG8_SB(0, 0), cB, voffB); PG8_STAGE(PG8_SB(0, 1), cB + hstep, voffB); PG8_STAGE(PG8_SA(0, 0), cA, voffA); PG8_STAGE(PG8_SA(0, 1), cA + hstep, voffA);
        if (wr == 1) PG8_BAR;
        PG8_WAIT_V(2); PG8_BAR;
        PG8_STAGE(PG8_SB(1, 0), cB + kstep, voffB); PG8_STAGE(PG8_SA(1, 0), cA + kstep, voffA); PG8_STAGE(PG8_SB(1, 1), cB + hstep + kstep, voffB);
        PG8_WAIT_V(6); PG8_BAR;
    } else {
        PG8_STAGE(PG8_SB(0, 0), cB, voffB); PG8_STAGE(PG8_SA(0, 0), cA, voffA); PG8_STAGE(PG8_SB(0, 1), cB + hstep, voffB); PG8_STAGE(PG8_SA(0, 1), cA + hstep, voffA);
        if (wr == 1) PG8_BAR;
        PG8_WAIT_V(4); PG8_BAR;
        PG8_STAGE(PG8_SB(1, 0), cB + kstep, voffB); PG8_STAGE(PG8_SA(1, 0), cA + kstep, voffA); PG8_STAGE(PG8_SB(1, 1), cB + hstep + kstep, voffB);
        PG8_WAIT_V(6); PG8_BAR;
    }
    for (;;) {
        const bool has_next = S.next(ui + 1, nxt);
        const char* nA = has_next ? (const char*)g.A + (size_t)nxt.pm * tstep : cA; const char* nB = has_next ? (const char*)g.Bt + (size_t)nxt.pn * tstep : cB;
        for (int t = 0; t < nt; t += 2) {
            const bool last = (t == nt - 2);
            const char* a1 = cA + (size_t)(t + 1) * kstep;
            const char* a2 = last ? nA : cA + (size_t)(t + 2) * kstep; const char* b2 = last ? nB : cB + (size_t)(t + 2) * kstep;
            const char* a3 = a2 + kstep; const char* b3 = b2 + kstep;
            if (last && has_next) S.a_ready(nxt);
            if constexpr (SP2) {
            PG8_LDB(B0, 0, 0); PG8_LDB(B1, 0, 1); PG8_SCHED; PG8_LDA(At, 0, 0); PG8_STAGE(PG8_SA(1, 1), a1 + hstep, voffA);
            PG8_WAIT_V(8); PG8_WAIT_L(0); PG8_BAR; PG8_MMA(0, 0, At, B0); PG8_MMA(0, 1, At, B1); PG8_BAR; PG8_SCHED;
            PG8_LDA(At, 0, 1); PG8_STAGE(PG8_SB(0, 0), b2, voffB); PG8_STAGE(PG8_SB(0, 1), b2 + hstep, voffB); PG8_STAGE(PG8_SA(0, 0), a2, voffA);
            PG8_WAIT_V(8); PG8_WAIT_L(0); PG8_BAR; PG8_MMA(1, 0, At, B0); PG8_MMA(1, 1, At, B1); PG8_BAR; PG8_SCHED;
            PG8_LDB(B0, 1, 0); PG8_LDB(B1, 1, 1); PG8_SCHED; PG8_LDA(At, 1, 0); PG8_STAGE(PG8_SA(0, 1), a2 + hstep, voffA);
            PG8_WAIT_V(8); PG8_WAIT_L(0); PG8_BAR; PG8_MMA(0, 0, At, B0); PG8_MMA(0, 1, At, B1); PG8_BAR; PG8_SCHED;
            PG8_LDA(At, 1, 1); PG8_STAGE(PG8_SB(1, 0), b3, voffB); PG8_STAGE(PG8_SB(1, 1), b3 + hstep, voffB); PG8_STAGE(PG8_SA(1, 0), a3, voffA);
            PG8_WAIT_V(8); PG8_WAIT_L(0); PG8_BAR; PG8_MMA(1, 0, At, B0); PG8_MMA(1, 1, At, B1); PG8_BAR; PG8_SCHED;
            } else {
            PG8_LDB(B0, 0, 0); PG8_SCHED; PG8_LDA(At, 0, 0); PG8_STAGE(PG8_SA(1, 1), a1 + hstep, voffA);
            PG8_WAIT_L(8); PG8_BAR; PG8_WAIT_L(0); PG8_MMA(0, 0, At, B0); PG8_BAR; PG8_SCHED;
            PG8_LDB(B1, 0, 1); PG8_STAGE(PG8_SB(0, 0), b2, voffB);
            PG8_BAR; PG8_WAIT_L(0); PG8_MMA(0, 1, At, B1); PG8_BAR;
            PG8_LDA(At, 0, 1); PG8_STAGE(PG8_SA(0, 0), a2, voffA);
            PG8_BAR; PG8_WAIT_L(0); PG8_MMA(1, 0, At, B0); PG8_BAR; PG8_SCHED;
            PG8_STAGE(PG8_SB(0, 1), b2 + hstep, voffB);
            PG8_WAIT_V(6); PG8_BAR; PG8_MMA(1, 1, At, B1); PG8_BAR;
            PG8_LDB(B0, 1, 0); PG8_SCHED; PG8_LDA(At, 1, 0); PG8_STAGE(PG8_SA(0, 1), a2 + hstep, voffA);
            PG8_WAIT_L(8); PG8_BAR; PG8_WAIT_L(0); PG8_MMA(0, 0, At, B0); PG8_BAR; PG8_SCHED;
            PG8_LDB(B1, 1, 1); PG8_STAGE(PG8_SB(1, 0), b3, voffB);
            PG8_BAR; PG8_WAIT_L(0); PG8_MMA(0, 1, At, B1); PG8_BAR;
            PG8_LDA(At, 1, 1); PG8_STAGE(PG8_SA(1, 0), a3, voffA);
            PG8_BAR; PG8_WAIT_L(0); PG8_MMA(1, 0, At, B0); PG8_BAR; PG8_SCHED;
            PG8_STAGE(PG8_SB(1, 1), b3 + hstep, voffB);
            PG8_WAIT_V(6); PG8_BAR; PG8_MMA(1, 1, At, B1); PG8_BAR;
            }
        }
        if constexpr (ALIGN_EPI) { if (wr == 0) PG8_BAR; }
        if constexpr (!Epi::AFTER_DRAIN) { E(acc, cur, wr, wc, fr, fq); S.done(cur); }
        if (!has_next) break;
#pragma unroll
        for (int a = 0; a < 2; ++a)
#pragma unroll
            for (int b = 0; b < 2; ++b)
#pragma unroll
                for (int m = 0; m < 4; ++m)
#pragma unroll
                    for (int n = 0; n < 2; ++n) acc[a][b][m][n] = (f32x4){0.f, 0.f, 0.f, 0.f};
        cur = nxt; cA = nA; cB = nB; ++ui;
        if constexpr (ALIGN_EPI) { if (wr == 1) PG8_BAR; }
    }
    PG8_WAIT_V(0);
    if constexpr (!ALIGN_EPI) { if (wr == 0) PG8_BAR; }
    PG8_BAR;
    if constexpr (Epi::AFTER_DRAIN) { E.fused(acc, cur, wr, wc, fr, fq, lds, wid, lane); S.done(cur); }
#undef PG8_SA
#undef PG8_SB
#undef PG8_STAGE
#undef PG8_LDA
#undef PG8_LDB
#undef PG8_MMA
#undef PG8_WAIT_V
#undef PG8_WAIT_L
#undef PG8_BAR
#undef PG8_SCHED
}
}
namespace pg8 {
struct Gemm2 { const bf16_t* A1; const bf16_t* B1t; int K1; const bf16_t* A2; const bf16_t* B2t; int K2; int M, N; };
template <class Epi, class Sched>
__device__ __forceinline__ void gemm_phase2(PG8_LAS unsigned char* lds, const Gemm2 g, const Sched& S, const Epi& E) {
    const int tid = threadIdx.x, wid = __builtin_amdgcn_readfirstlane(tid >> 6), lane = tid & 63, wr = wid >> 2, wc = wid & 3, fr = lane & 15, fq = lane >> 4;
    const int nt1 = g.K1 / BK, nt = nt1 + g.K2 / BK;
    unsigned rA2[2], rB2[2], c2[2];
#pragma unroll
    for (int i = 0; i < 2; ++i) { int R, C; stage_rc(tid * 16 + i * 8192, R, C); const int Rb = Epi::PERM ? ((R & ~31) + perm32(R & 31)) : R;
        rA2[i] = (unsigned)R * 2u; rB2[i] = (unsigned)Rb * 2u; c2[i] = (unsigned)C * 2u; }

    const size_t kstep = (size_t)(BK * 2);
    const size_t hstep1 = (size_t)HALF * g.K1 * 2, hstep2 = (size_t)HALF * g.K2 * 2;
    const unsigned ldsw = (unsigned)wid * 1024u;
    const int aoff = lds_byte(wr * 64 + fr, fq * 8), boff = lds_byte(wc * 32 + fr, fq * 8);
#define PG8_SA(b, h) (((b) * 2 + (h)) * HTB)
#define PG8_SB(b, h) ((4 + (b) * 2 + (h)) * HTB)
#define PG8_STAGE(bufoff, gbase, voff) do { _Pragma("unroll") for (int _i = 0; _i < 2; ++_i) \
        __builtin_amdgcn_global_load_lds((const unsigned*)((const char*)(gbase) + (voff)[_i]), (PG8_LAS unsigned*)(lds + (bufoff) + ldsw + _i * 8192), 16, 0, 0); } while (0)
#define PG8_LDA(dst, b, h) do { _Pragma("unroll") for (int m = 0; m < 4; ++m) _Pragma("unroll") for (int k = 0; k < 2; ++k) dst[m][k] = *(const PG8_LAS bf16x8*)(lds + PG8_SA(b, h) + aoff + m * 2048 + k * 1024); } while (0)
#define PG8_LDB(dst, b, h) do { _Pragma("unroll") for (int n = 0; n < 2; ++n) _Pragma("unroll") for (int k = 0; k < 2; ++k) dst[n][k] = *(const PG8_LAS bf16x8*)(lds + PG8_SB(b, h) + boff + n * 2048 + k * 1024); } while (0)
#define PG8_MMA(ai, bj, At, Bt) do { __builtin_amdgcn_s_setprio(1); _Pragma("unroll") for (int m = 0; m < 4; ++m) _Pragma("unroll") for (int n = 0; n < 2; ++n) _Pragma("unroll") for (int k = 0; k < 2; ++k) \
        acc[ai][bj][m][n] = __builtin_amdgcn_mfma_f32_16x16x32_bf16(Bt[n][k], At[m][k], acc[ai][bj][m][n], 0, 0, 0); __builtin_amdgcn_s_setprio(0); } while (0)
#define PG8_WAIT_V(n) asm volatile("s_waitcnt vmcnt(" #n ")" ::: "memory")
#define PG8_WAIT_L(n) asm volatile("s_waitcnt lgkmcnt(" #n ")" ::: "memory")
#define PG8_BAR __builtin_amdgcn_s_barrier()
#define PG8_SCHED __builtin_amdgcn_sched_barrier(0)
    Unit cur, nxt; int ui = 0;
    if (!S.next(0, cur)) return;
    f32x4 acc[2][2][4][2];
#pragma unroll
    for (int a = 0; a < 2; ++a)
#pragma unroll
        for (int b = 0; b < 2; ++b)
#pragma unroll
            for (int m = 0; m < 4; ++m)
#pragma unroll
                for (int n = 0; n < 2; ++n) acc[a][b][m][n] = (f32x4){0.f, 0.f, 0.f, 0.f};
    bf16x8 At[4][2], B0[2][2], B1[2][2];
    const char* cA1 = (const char*)g.A1 + (size_t)cur.pm * 2 * hstep1; const char* cB1 = (const char*)g.B1t + (size_t)cur.pn * 2 * hstep1;
    const char* cA2 = (const char*)g.A2 + (size_t)cur.pm * 2 * hstep2; const char* cB2 = (const char*)g.B2t + (size_t)cur.pn * 2 * hstep2;
    {
    unsigned voffA1[2], voffB1[2];
#pragma unroll
    for (int i = 0; i < 2; ++i) { voffA1[i] = rA2[i] * (unsigned)g.K1 + c2[i]; voffB1[i] = rB2[i] * (unsigned)g.K1 + c2[i]; }
    PG8_STAGE(PG8_SB(0, 0), cB1, voffB1); PG8_STAGE(PG8_SB(0, 1), cB1 + hstep1, voffB1); PG8_STAGE(PG8_SA(0, 0), cA1, voffA1); PG8_STAGE(PG8_SA(0, 1), cA1 + hstep1, voffA1);
    if (wr == 1) PG8_BAR;
    PG8_WAIT_V(2); PG8_BAR;
    PG8_STAGE(PG8_SB(1, 0), cB1 + kstep, voffB1); PG8_STAGE(PG8_SA(1, 0), cA1 + kstep, voffA1); PG8_STAGE(PG8_SB(1, 1), cB1 + hstep1 + kstep, voffB1);
    PG8_WAIT_V(6); PG8_BAR;
    }
    for (;;) {
        const bool has_next = S.next(ui + 1, nxt);
        const char* nA1 = has_next ? (const char*)g.A1 + (size_t)nxt.pm * 2 * hstep1 : cA1; const char* nB1 = has_next ? (const char*)g.B1t + (size_t)nxt.pn * 2 * hstep1 : cB1;
        for (int t = 0; t < nt; t += 2) {
            const bool last = (t == nt - 2);
            const bool s1 = (t >= nt1);
            const bool s2 = !last && (t + 2 >= nt1);
            const char* a1 = s1 ? cA2 + (size_t)(t + 1 - nt1) * kstep : cA1 + (size_t)(t + 1) * kstep;
            const size_t h1 = s1 ? hstep2 : hstep1, h2 = s2 ? hstep2 : hstep1;
            const char* a2 = last ? nA1 : (s2 ? cA2 + (size_t)(t + 2 - nt1) * kstep : cA1 + (size_t)(t + 2) * kstep);
            const char* b2 = last ? nB1 : (s2 ? cB2 + (size_t)(t + 2 - nt1) * kstep : cB1 + (size_t)(t + 2) * kstep);
            const char* a3 = a2 + kstep; const char* b3 = b2 + kstep;
            const unsigned k1 = (unsigned)(s1 ? g.K2 : g.K1), k2 = (unsigned)(s2 ? g.K2 : g.K1);
            unsigned vA1[2], vA2[2], vB2[2];
#pragma unroll
            for (int i = 0; i < 2; ++i) { vA1[i] = rA2[i] * k1 + c2[i]; vA2[i] = rA2[i] * k2 + c2[i]; vB2[i] = rB2[i] * k2 + c2[i]; }
            if (t == nt1) E.mid(acc, cur, wr, wc, fr, fq);
            PG8_LDB(B0, 0, 0); PG8_LDB(B1, 0, 1); PG8_SCHED; PG8_LDA(At, 0, 0); PG8_STAGE(PG8_SA(1, 1), a1 + h1, vA1);
            PG8_WAIT_V(8); PG8_WAIT_L(0); PG8_BAR; PG8_MMA(0, 0, At, B0); PG8_MMA(0, 1, At, B1); PG8_BAR; PG8_SCHED;
            PG8_LDA(At, 0, 1); PG8_STAGE(PG8_SB(0, 0), b2, vB2); PG8_STAGE(PG8_SB(0, 1), b2 + h2, vB2); PG8_STAGE(PG8_SA(0, 0), a2, vA2);
            PG8_WAIT_V(8); PG8_WAIT_L(0); PG8_BAR; PG8_MMA(1, 0, At, B0); PG8_MMA(1, 1, At, B1); PG8_BAR; PG8_SCHED;
            PG8_LDB(B0, 1, 0); PG8_LDB(B1, 1, 1); PG8_SCHED; PG8_LDA(At, 1, 0); PG8_STAGE(PG8_SA(0, 1), a2 + h2, vA2);
            PG8_WAIT_V(8); PG8_WAIT_L(0); PG8_BAR; PG8_MMA(0, 0, At, B0); PG8_MMA(0, 1, At, B1); PG8_BAR; PG8_SCHED;
            PG8_LDA(At, 1, 1); PG8_STAGE(PG8_SB(1, 0), b3, vB2); PG8_STAGE(PG8_SB(1, 1), b3 + h2, vB2); PG8_STAGE(PG8_SA(1, 0), a3, vA2);
            PG8_WAIT_V(8); PG8_WAIT_L(0); PG8_BAR; PG8_MMA(1, 0, At, B0); PG8_MMA(1, 1, At, B1); PG8_BAR; PG8_SCHED;
        }
        if (wr == 0) PG8_BAR;
        E(acc, cur, wr, wc, fr, fq);
        if (!has_next) break;
#pragma unroll
        for (int a = 0; a < 2; ++a)
#pragma unroll
            for (int b = 0; b < 2; ++b)
#pragma unroll
                for (int m = 0; m < 4; ++m)
#pragma unroll
                    for (int n = 0; n < 2; ++n) acc[a][b][m][n] = (f32x4){0.f, 0.f, 0.f, 0.f};
        cur = nxt; cA1 = nA1; cB1 = nB1;
        cA2 = (const char*)g.A2 + (size_t)cur.pm * 2 * hstep2; cB2 = (const char*)g.B2t + (size_t)cur.pn * 2 * hstep2; ++ui;
        if (wr == 1) PG8_BAR;
    }
    PG8_WAIT_V(0);
    PG8_BAR;
#undef PG8_SA
#undef PG8_SB
#undef PG8_STAGE
#undef PG8_LDA
#undef PG8_LDB
#undef PG8_MMA
#undef PG8_WAIT_V
#undef PG8_WAIT_L
#undef PG8_BAR
#undef PG8_SCHED
}
}

#define LAS __attribute__((address_space(3)))
typedef unsigned short bf16;
typedef pg8::f32x4 f32x4;
typedef pg8::u32x4 u32x4;
typedef pg8::bf16x8 bf16x8;
typedef unsigned u32x2 __attribute__((ext_vector_type(2)));
typedef float f32x2v __attribute__((ext_vector_type(2)));

constexpr int NB = 4, SEQ = 8192, D = 1024, M = NB * SEQ;
constexpr int NH = 4, DK = 256, DV = 512;
constexpr int NT1 = 24, NT2 = 20, NIN = (NT1 + NT2) * 256;
constexpr int NPHASE = 10;

constexpr size_t MiB = 1u << 20;
constexpr size_t WS_CTL = 0, CTL_BYTES = 1 * MiB;
constexpr size_t WS_MOD = 1 * MiB;
constexpr size_t WS_WIN = 2 * MiB;
constexpr size_t WS_WRET = 24 * MiB;
constexpr size_t WS_WCONV = 28 * MiB;
constexpr size_t WS_WOUT = 30 * MiB;
constexpr size_t WS_H = 32 * MiB;
constexpr size_t WS_Q = 96 * MiB;
constexpr size_t WS_K = 160 * MiB;
constexpr size_t WS_V = 224 * MiB;
constexpr size_t WS_ZR = 352 * MiB;
constexpr size_t WS_END = 480 * MiB;
constexpr int CW_BAR = 4096;

typedef float f32x2_t __attribute__((ext_vector_type(2)));
typedef __bf16 bf16x2_t __attribute__((ext_vector_type(2)));
__device__ __forceinline__ unsigned cvt_pk(float lo, float hi) { const f32x2_t v = {lo, hi}; const bf16x2_t b = __builtin_convertvector(v, bf16x2_t); return __builtin_bit_cast(unsigned, b); }
__device__ __forceinline__ float bf_lo(unsigned u) { return __uint_as_float(u << 16); }
__device__ __forceinline__ float bf_hi(unsigned u) { return __uint_as_float(u & 0xffff0000u); }
__device__ __forceinline__ float fsigmoid(float x) { return __builtin_amdgcn_rcpf(1.0f + __builtin_amdgcn_exp2f(x * -1.4426950408889634f)); }
__device__ __forceinline__ float fsilu(float x) { return x * fsigmoid(x); }

struct EpiProj1 {
    static constexpr bool PERM = true, AFTER_DRAIN = false;
    bf16* Q; bf16* K; bf16* V; bf16* ZR; const int* pos;
    __device__ __forceinline__ void operator()(const f32x4 (&acc)[2][2][4][2], const pg8::Unit& u, int wr, int wc, int fr, int fq) const {
        const int row0 = u.pm * 256 + wr * 64 + fr, cb = wc * 32 + 8 * fq, pn = u.pn;
        if (pn < 8) {
            bf16* base = (pn < 4 ? Q : K) + (pn & 3) * 256 + cb;
            const float sc = pn < 4 ? 1.0f : 0.0625f;
            float invf[8];
#pragma unroll
            for (int i = 0; i < 8; ++i) invf[i] = exp2f((float)(cb + i) * (-13.287712379549449f / 128.0f));
#pragma unroll
            for (int ai = 0; ai < 2; ++ai)
#pragma unroll
                for (int m = 0; m < 4; ++m) {
                    const int row = row0 + ai * 128 + m * 16;
                    const float p = (float)pos[row];
                    float o1[8], o2[8];
#pragma unroll
                    for (int n = 0; n < 2; ++n)
#pragma unroll
                        for (int j = 0; j < 4; ++j) {
                            const float ang = p * invf[n * 4 + j];
                            const float nn = rintf(ang * 0.15915494309189535f);
                            float r = fmaf(-nn, 6.2831854820251465f, ang);
                            r = fmaf(-nn, -1.7484555e-7f, r);
                            const float rv = r * 0.15915494309189535f;
                            const float s = __builtin_amdgcn_sinf(rv), c = __builtin_amdgcn_cosf(rv);
                            const float t1 = acc[ai][0][m][n][j], t2 = acc[ai][1][m][n][j];
                            o1[n * 4 + j] = (t1 * c - t2 * s) * sc; o2[n * 4 + j] = (t1 * s + t2 * c) * sc;
                        }
                    bf16* rp = base + (size_t)row * 1024;
                    u32x4 w1, w2;
                    w1.x = cvt_pk(o1[0], o1[1]); w1.y = cvt_pk(o1[2], o1[3]); w1.z = cvt_pk(o1[4], o1[5]); w1.w = cvt_pk(o1[6], o1[7]);
                    w2.x = cvt_pk(o2[0], o2[1]); w2.y = cvt_pk(o2[2], o2[3]); w2.z = cvt_pk(o2[4], o2[5]); w2.w = cvt_pk(o2[6], o2[7]);
                    *(u32x4*)rp = w1; *(u32x4*)(rp + 128) = w2;
                }
        } else {
            const bool act = pn >= 16;
            bf16* base = (act ? ZR + (pn - 16) * 256 : V + (pn - 8) * 256) + cb;
#pragma unroll
            for (int ai = 0; ai < 2; ++ai)
#pragma unroll
                for (int m = 0; m < 4; ++m) {
                    bf16* rp = base + (size_t)(row0 + ai * 128 + m * 16) * 2048;
#pragma unroll
                    for (int bj = 0; bj < 2; ++bj) {
                        f32x4 v0 = acc[ai][bj][m][0], v1 = acc[ai][bj][m][1];
                        if (act) {
#pragma unroll
                            for (int j = 0; j < 4; ++j) { v0[j] = fsilu(v0[j]); v1[j] = fsilu(v1[j]); }
                        }
                        u32x4 w; w.x = cvt_pk(v0[0], v0[1]); w.y = cvt_pk(v0[2], v0[3]); w.z = cvt_pk(v1[0], v1[1]); w.w = cvt_pk(v1[2], v1[3]);
                        *(u32x4*)(rp + bj * 128) = w;
                    }
                }
        }
    }
};
struct EpiProj2 {
    static constexpr bool PERM = true, AFTER_DRAIN = false;
    bf16* A; bf16* ZC; bf16* SGA; bf16* SGB;
    __device__ __forceinline__ void operator()(const f32x4 (&acc)[2][2][4][2], const pg8::Unit& u, int wr, int wc, int fr, int fq) const {
        const int row0 = u.pm * 256 + wr * 64 + fr, cb = wc * 32 + 8 * fq, pn = u.pn;
        if (pn < 8) {
            bf16* base = A + pn * 128 + cb;
#pragma unroll
            for (int ai = 0; ai < 2; ++ai)
#pragma unroll
                for (int m = 0; m < 4; ++m) {
                    f32x4 v0 = acc[ai][0][m][0], v1 = acc[ai][0][m][1]; const f32x4 g0 = acc[ai][1][m][0], g1 = acc[ai][1][m][1];
#pragma unroll
                    for (int j = 0; j < 4; ++j) { v0[j] *= fsigmoid(g0[j]); v1[j] *= fsigmoid(g1[j]); }
                    u32x4 w; w.x = cvt_pk(v0[0], v0[1]); w.y = cvt_pk(v0[2], v0[3]); w.z = cvt_pk(v1[0], v1[1]); w.w = cvt_pk(v1[2], v1[3]);
                    *(u32x4*)(base + (size_t)(row0 + ai * 128 + m * 16) * 1024) = w;
                }
        } else {
            const bool isz = pn < 12;
            bf16* base = (isz ? ZC + (pn - 8) * 256 : (pn < 16 ? SGA + (pn - 12) * 256 : SGB + (pn - 16) * 256)) + cb;
#pragma unroll
            for (int ai = 0; ai < 2; ++ai)
#pragma unroll
                for (int m = 0; m < 4; ++m) {
                    bf16* rp = base + (size_t)(row0 + ai * 128 + m * 16) * 1024;
#pragma unroll
                    for (int bj = 0; bj < 2; ++bj) {
                        f32x4 v0 = acc[ai][bj][m][0], v1 = acc[ai][bj][m][1];
#pragma unroll
                        for (int j = 0; j < 4; ++j) { const float s0 = fsigmoid(v0[j]), s1 = fsigmoid(v1[j]); v0[j] = isz ? v0[j] * s0 : s0; v1[j] = isz ? v1[j] * s1 : s1; }
                        u32x4 w; w.x = cvt_pk(v0[0], v0[1]); w.y = cvt_pk(v0[2], v0[3]); w.z = cvt_pk(v1[0], v1[1]); w.w = cvt_pk(v1[2], v1[3]);
                        *(u32x4*)(rp + bj * 128) = w;
                    }
                }
        }
    }
};
typedef unsigned v4u_t __attribute__((__vector_size__(4 * sizeof(unsigned))));
#define EB_RSRC(p) __builtin_amdgcn_make_buffer_rsrc((void*)(p), (short)0, 0x7fffffff, 0x00020000)
struct EpiMerge {
    static constexpr bool PERM = true, AFTER_DRAIN = false;
    const bf16* SGA; const bf16* SGB; bf16* MG;
    __device__ __forceinline__ void mid(f32x4 (&acc)[2][2][4][2], const pg8::Unit& u, int wr, int wc, int fr, int fq) const {
        const __amdgpu_buffer_rsrc_t ra = EB_RSRC(SGA), rb = EB_RSRC(SGB);
        const unsigned vo = (unsigned)(((u.pm * 256 + wr * 64 + fr) * 1024 + u.pn * 256 + wc * 32 + 8 * fq) * 2);
#pragma unroll
        for (int ai = 0; ai < 2; ++ai)
#pragma unroll
            for (int m = 0; m < 4; ++m)
#pragma unroll
                for (int bj = 0; bj < 2; ++bj) {
                    const int so = ((ai * 128 + m * 16) * 1024 + bj * 128) * 2;
                    const u32x4 a = __builtin_bit_cast(u32x4, __builtin_amdgcn_raw_buffer_load_b128(ra, vo, so, 0)), b = __builtin_bit_cast(u32x4, __builtin_amdgcn_raw_buffer_load_b128(rb, vo, so, 0));
                    f32x4& v0 = acc[ai][bj][m][0]; f32x4& v1 = acc[ai][bj][m][1];
                    v0[0] *= bf_lo(a.x) * __builtin_amdgcn_rcpf(bf_lo(b.x)); v0[1] *= bf_hi(a.x) * __builtin_amdgcn_rcpf(bf_hi(b.x)); v0[2] *= bf_lo(a.y) * __builtin_amdgcn_rcpf(bf_lo(b.y)); v0[3] *= bf_hi(a.y) * __builtin_amdgcn_rcpf(bf_hi(b.y));
                    v1[0] *= bf_lo(a.z) * __builtin_amdgcn_rcpf(bf_lo(b.z)); v1[1] *= bf_hi(a.z) * __builtin_amdgcn_rcpf(bf_hi(b.z)); v1[2] *= bf_lo(a.w) * __builtin_amdgcn_rcpf(bf_lo(b.w)); v1[3] *= bf_hi(a.w) * __builtin_amdgcn_rcpf(bf_hi(b.w));
                }
    }
    __device__ __forceinline__ void operator()(const f32x4 (&acc)[2][2][4][2], const pg8::Unit& u, int wr, int wc, int fr, int fq) const {
        const __amdgpu_buffer_rsrc_t rb = EB_RSRC(SGB), rm = EB_RSRC(MG);
        const unsigned vo = (unsigned)(((u.pm * 256 + wr * 64 + fr) * 1024 + u.pn * 256 + wc * 32 + 8 * fq) * 2);
#pragma unroll
        for (int ai = 0; ai < 2; ++ai)
#pragma unroll
            for (int m = 0; m < 4; ++m)
#pragma unroll
                for (int bj = 0; bj < 2; ++bj) {
                    const int so = ((ai * 128 + m * 16) * 1024 + bj * 128) * 2;
                    const u32x4 g = __builtin_bit_cast(u32x4, __builtin_amdgcn_raw_buffer_load_b128(rb, vo, so, 0));
                    const f32x4 v0 = acc[ai][bj][m][0], v1 = acc[ai][bj][m][1];
                    u32x4 w; w.x = cvt_pk(v0[0] * bf_lo(g.x), v0[1] * bf_hi(g.x)); w.y = cvt_pk(v0[2] * bf_lo(g.y), v0[3] * bf_hi(g.y)); w.z = cvt_pk(v1[0] * bf_lo(g.z), v1[1] * bf_hi(g.z)); w.w = cvt_pk(v1[2] * bf_lo(g.w), v1[3] * bf_hi(g.w));
                    __builtin_amdgcn_raw_buffer_store_b128(__builtin_bit_cast(v4u_t, w), rm, vo, so, 0);
                }
    }
};
struct EpiY {
    static constexpr bool PERM = true, AFTER_DRAIN = false;
    bf16* Y;
    __device__ __forceinline__ void operator()(const f32x4 (&acc)[2][2][4][2], const pg8::Unit& u, int wr, int wc, int fr, int fq) const {
        const int row0 = u.pm * 256 + wr * 64 + fr, col0 = u.pn * 256 + wc * 32 + 8 * fq;
#pragma unroll
        for (int ai = 0; ai < 2; ++ai)
#pragma unroll
            for (int m = 0; m < 4; ++m) {
                bf16* rp = Y + (size_t)(row0 + ai * 128 + m * 16) * 1024 + col0;
#pragma unroll
                for (int bj = 0; bj < 2; ++bj) { const f32x4 v0 = acc[ai][bj][m][0], v1 = acc[ai][bj][m][1];
                    u32x4 w; w.x = cvt_pk(v0[0], v0[1]); w.y = cvt_pk(v0[2], v0[3]); w.z = cvt_pk(v1[0], v1[1]); w.w = cvt_pk(v1[2], v1[3]);
                    *(u32x4*)(rp + bj * 128) = w; }
            }
    }
};
#define XB_TMO      128
#define XB_XCNT(j)  (256  + 64 * (j))
#define XB_XSUB(j)  (1280 + 64 * (j))
#define XB_XGEN(j)  (2304 + 64 * (j))
#define XB_TOP      3328
#define XB_TOPGEN   3392
#define XCD_BAR_WORDS 3456
#define XB_SPIN_CAP (1u << 18)

__device__ __forceinline__ unsigned xb_ld(unsigned* p)              { return __hip_atomic_load(p, __ATOMIC_RELAXED, __HIP_MEMORY_SCOPE_AGENT); }
__device__ __forceinline__ unsigned xb_add(unsigned* p, unsigned v) { return __hip_atomic_fetch_add(p, v, __ATOMIC_RELAXED, __HIP_MEMORY_SCOPE_AGENT); }
__device__ __forceinline__ unsigned xb_xcc_id() { return (unsigned)__builtin_amdgcn_s_getreg((3 << 11) | 20) & 0xFu; }
#define XB_SPIN(cond, bar) do { unsigned _sp = 0; while (cond) { __builtin_amdgcn_s_sleep(1); \
    if ((++_sp & 255u) == 0u) { if (xb_ld(&(bar)[XB_TMO])) break; if (_sp > XB_SPIN_CAP) { atomicAdd(&(bar)[XB_TMO], 1u); break; } } } } while (0)

struct XcdBarrier {
    unsigned* bar; unsigned x;
    volatile LAS unsigned* st;
};

__device__ __forceinline__ XcdBarrier xcd_barrier_post(unsigned* bar, volatile LAS unsigned* st) {
    XcdBarrier b; b.bar = bar; b.x = xb_xcc_id(); b.st = st;
    if (threadIdx.x == 0) (void)xb_add(&bar[XB_XCNT(b.x)], 1u);
    return b;
}
__device__ __forceinline__ void xcd_barrier_complete(unsigned* bar, unsigned x, unsigned& nloc, unsigned& nx) {
    const unsigned G = gridDim.x * gridDim.y * gridDim.z;
    unsigned sum, cnt, mine, sp = 0u;
    for (;;) {
        sum = 0u; cnt = 0u; mine = 0u;
#pragma unroll
        for (unsigned j = 0; j < 16; ++j) { const unsigned c = xb_ld(&bar[XB_XCNT(j)]); sum += c; cnt += (c > 0u) ? 1u : 0u; mine = (j == x) ? c : mine; }
        if (sum == G) break;
        __builtin_amdgcn_s_sleep(1);
        if ((++sp & 255u) == 0u) { if (xb_ld(&bar[XB_TMO])) break; if (sp > XB_SPIN_CAP) { atomicAdd(&bar[XB_TMO], 1u); break; } }
    }
    nloc = mine > 0u ? mine : 1u; nx = cnt > 0u ? cnt : 1u;
}

__device__ __forceinline__ void xcd_barrier(const XcdBarrier& b) {
    asm volatile("s_waitcnt vmcnt(0)" ::: "memory");
    __syncthreads();
    if (threadIdx.x == 0) {
        unsigned* bar = b.bar;
        __builtin_amdgcn_s_waitcnt(0);
        unsigned nloc = b.st[0], nx = b.st[1];
        if (nloc == 0u) { xcd_barrier_complete(bar, b.x, nloc, nx); b.st[0] = nloc; b.st[1] = nx; }
        const unsigned old = xb_add(&bar[XB_XSUB(b.x)], 1u);
        const unsigned gen = old / nloc;
        if (old + 1u == (gen + 1u) * nloc) {
            __builtin_amdgcn_fence(__ATOMIC_RELEASE, "agent");
            asm volatile("s_waitcnt vmcnt(0)" ::: "memory");
            const unsigned og = xb_add(&bar[XB_TOP], 1u);
            const unsigned tg = og / nx;
            if (og + 1u == (tg + 1u) * nx) xb_add(&bar[XB_TOPGEN], 1u);
            else XB_SPIN(xb_ld(&bar[XB_TOPGEN]) == tg, bar);
            __builtin_amdgcn_fence(__ATOMIC_ACQUIRE, "agent");
            xb_add(&bar[XB_XGEN(b.x)], 1u);
            asm volatile("s_waitcnt vmcnt(0)" ::: "memory");
        } else {
            XB_SPIN(xb_ld(&bar[XB_XGEN(b.x)]) == gen, bar);
            __builtin_amdgcn_fence(__ATOMIC_ACQUIRE, "agent");
            asm volatile("s_waitcnt vmcnt(0)" ::: "memory");
        }
    }
    __syncthreads();
}

constexpr int RING_BYTES = 131072;
constexpr int LDSCTL_OFF = RING_BYTES, MISC_OFF = LDSCTL_OFF + 320;
constexpr int LDS_BYTES = 147456;
struct Frame {
    LAS unsigned char* lds;
    volatile LAS unsigned* MISC;
    unsigned* ctl;
    int tid, lane, wave, vcu, G;
    const float *x, *c, *w_ada, *b_ada, *pre_g, *w_in, *conv_w, *conv_b, *ln_g, *ln_b, *w_ret, *w_conv, *w_out, *post_g;
    const int* pos;
    float* out; float* mod;
    bf16 *WIN, *WRET, *WCONV, *WOUT, *H, *Q, *K, *V, *ZR, *SGA, *SGB;
    float* F32S;
    bf16* YB;
};
#define DPP_ADD(v, ctrl, row_mask) ((v) + __int_as_float(__builtin_amdgcn_update_dpp(0, __float_as_int(v), ctrl, row_mask, 0xF, true)))
__device__ __forceinline__ float wave_sum(float v) {
    v = DPP_ADD(v, 0xB1, 0xF);
    v = DPP_ADD(v, 0x4E, 0xF);
    v = DPP_ADD(v, 0x141, 0xF);
    v = DPP_ADD(v, 0x140, 0xF);
    v = DPP_ADD(v, 0x142, 0xA);
    v = DPP_ADD(v, 0x143, 0xC);
    return __int_as_float(__builtin_amdgcn_readlane(__float_as_int(v), 63));
}
#define LDS_WAIT() asm volatile("s_waitcnt lgkmcnt(0)" ::: "memory")
#define RAW_BAR() do { asm volatile("s_waitcnt lgkmcnt(0)" ::: "memory"); __builtin_amdgcn_s_barrier(); asm volatile("" ::: "memory"); } while (0)

__device__ __forceinline__ void transpose_item(const float* W, int K, int N, bf16* WT, int dst_row0, int src_col0, int k0, LAS float* scr, int lane) {
#pragma unroll 8
    for (int i = 0; i < 32; ++i) { const int kk = 2 * i + (lane >> 5); scr[kk * 33 + (lane & 31)] = W[(size_t)(k0 + kk) * N + src_col0 + (lane & 31)]; }
    LDS_WAIT(); asm volatile("" ::: "memory");
    const int c = lane & 7;
#pragma unroll
    for (int j = 0; j < 4; ++j) { const int n = (lane >> 3) + 8 * j; const LAS float* s = scr + (8 * c) * 33 + n;
        u32x4 o; o.x = cvt_pk(s[0 * 33], s[1 * 33]); o.y = cvt_pk(s[2 * 33], s[3 * 33]); o.z = cvt_pk(s[4 * 33], s[5 * 33]); o.w = cvt_pk(s[6 * 33], s[7 * 33]);
        *(u32x4*)(WT + (size_t)(dst_row0 + n) * K + k0 + 8 * c) = o; }
    LDS_WAIT(); asm volatile("" ::: "memory");
}
__device__ __forceinline__ int win_src_col(int n0) {
    if (n0 >= 6144 && n0 < 8192) { const int t = (n0 - 6144) >> 8, wi = (n0 - 6144) & 255; return wi < 128 ? 6144 + 128 * t + wi : 7168 + 128 * t + (wi - 128); }
    return n0;
}
__device__ __forceinline__ void phase0(Frame& F) {
    LAS float* red = (LAS float*)F.lds;
    for (int cg = blockIdx.x; cg < 48; cg += F.G) {
        const int col = cg * 64 + F.lane; float a0 = 0.f, a1 = 0.f, a2 = 0.f, a3 = 0.f;
        const int kb = F.wave * 128;
#pragma unroll 16
        for (int k = 0; k < 128; ++k) { const float wv = F.w_ada[(size_t)(kb + k) * 3072 + col];
            a0 = fmaf(F.c[kb + k], wv, a0); a1 = fmaf(F.c[1024 + kb + k], wv, a1); a2 = fmaf(F.c[2048 + kb + k], wv, a2); a3 = fmaf(F.c[3072 + kb + k], wv, a3); }
        red[(F.wave * 4 + 0) * 64 + F.lane] = a0; red[(F.wave * 4 + 1) * 64 + F.lane] = a1; red[(F.wave * 4 + 2) * 64 + F.lane] = a2; red[(F.wave * 4 + 3) * 64 + F.lane] = a3;
        __syncthreads();
        if (F.wave < 4) { float s = 0.f;
#pragma unroll
            for (int w = 0; w < 8; ++w) s += red[(w * 4 + F.wave) * 64 + F.lane];
            F.mod[F.wave * 3072 + col] = s + F.b_ada[col]; }
        __syncthreads();
    }
    LAS float* scr = (LAS float*)(F.lds + F.wave * 8448);
    const int gw = F.vcu * 8 + F.wave, NGW = F.G * 8;
    constexpr int I_IN = 16 * 352, I_RET = 32 * 32, I_CV = 16 * 32, I_OUT = 16 * 32;
    for (int it = gw; it < I_IN + I_RET + I_CV + I_OUT; it += NGW) {
        int r = it;
        if (r < I_IN) { const int kb = r / 352, nb = r % 352; transpose_item(F.w_in, 1024, NIN, F.WIN, nb * 32, win_src_col(nb * 32), kb * 64, scr, F.lane); continue; } r -= I_IN;
        if (r < I_RET) { const int kb = r >> 5, nb = r & 31; transpose_item(F.w_ret, 2048, 1024, F.WRET, nb * 32, nb * 32, kb * 64, scr, F.lane); continue; } r -= I_RET;
        if (r < I_CV) { const int kb = r >> 5, nb = r & 31; transpose_item(F.w_conv, 1024, 1024, F.WCONV, nb * 32, nb * 32, kb * 64, scr, F.lane); continue; } r -= I_CV;
        { const int kb = r >> 5, nb = r & 31; transpose_item(F.w_out, 1024, 1024, F.WOUT, nb * 32, nb * 32, kb * 64, scr, F.lane); }
    }
}
__device__ __forceinline__ void phase1(Frame& F) {
    const int gw = F.vcu * 8 + F.wave, NGW = F.G * 8;
    for (int rb = gw; rb < M / 16; rb += NGW) {
        const int b = (rb * 16) / SEQ;
        f32x4 ca[4], cs[4];
#pragma unroll
        for (int j = 0; j < 4; ++j) { const int col = 4 * F.lane + 256 * j;
            const f32x4 g = *(const f32x4*)(F.pre_g + col), sc = *(const f32x4*)(F.mod + b * 3072 + 1024 + col);
            ca[j] = g * (sc + 1.0f); cs[j] = *(const f32x4*)(F.mod + b * 3072 + col); }
        for (int r = 0; r < 16; r += 4) {
            const size_t m = (size_t)rb * 16 + r;
            f32x4 v[4][4]; float ss[4];
#pragma unroll
            for (int q = 0; q < 4; ++q) { const f32x4* xr = (const f32x4*)(F.x + (m + q) * D) + F.lane;
#pragma unroll
                for (int j = 0; j < 4; ++j) v[q][j] = xr[64 * j]; }
#pragma unroll
            for (int q = 0; q < 4; ++q) { float s = 0.f;
#pragma unroll
                for (int j = 0; j < 4; ++j) s += (v[q][j][0] * v[q][j][0] + v[q][j][1] * v[q][j][1]) + (v[q][j][2] * v[q][j][2] + v[q][j][3] * v[q][j][3]);
                ss[q] = s; }
#pragma unroll
            for (int q = 0; q < 4; ++q) ss[q] = wave_sum(ss[q]);
#pragma unroll
            for (int q = 0; q < 4; ++q) { const float rstd = rsqrtf(ss[q] * (1.0f / D) + 1e-6f);
                u32x2* o8 = (u32x2*)(F.H + (m + q) * D) + F.lane;
#pragma unroll
                for (int j = 0; j < 4; ++j) { const f32x4 y = v[q][j] * rstd * ca[j] + cs[j]; u32x2 w; w.x = cvt_pk(y[0], y[1]); w.y = cvt_pk(y[2], y[3]); o8[64 * j] = w; } }
        }
    }
}
constexpr int R_ROW = 528, R_PROW = 160, R_VROW = 272;
constexpr int R_QS = 0, R_KS = 64 * R_ROW, R_P = 2 * 64 * R_ROW, R_VZ = R_P + 64 * R_PROW, R_END = R_VZ + 64 * R_VROW;
static_assert(R_END <= RING_BYTES, "retention LDS map");
typedef short v4i16_t __attribute__((ext_vector_type(4)));
__device__ __forceinline__ bf16x8 ldfrag(const LAS unsigned char* p) { return *(const LAS bf16x8*)p; }
__device__ __forceinline__ v4i16_t ldtr(const LAS unsigned char* p) { return __builtin_amdgcn_ds_read_tr16_b64_v4i16((LAS v4i16_t*)p); }
__device__ __forceinline__ bf16x8 ldtr2(const LAS unsigned char* p, int step) {
    const v4i16_t t0 = ldtr(p), t1 = ldtr(p + step);
    bf16x8 f; f[0] = t0[0]; f[1] = t0[1]; f[2] = t0[2]; f[3] = t0[3]; f[4] = t1[0]; f[5] = t1[1]; f[6] = t1[2]; f[7] = t1[3]; return f;
}
__device__ __forceinline__ bf16x8 ld2x64(const LAS unsigned char* p0, const LAS unsigned char* p1) {
    const u32x2 a = *(const volatile LAS u32x2*)p0, b = *(const volatile LAS u32x2*)p1;
    u32x4 r; r.x = a.x; r.y = a.y; r.z = b.x; r.w = b.y; return __builtin_bit_cast(bf16x8, r);
}
__device__ __forceinline__ bf16x8 state_frag(const f32x4& s0, const f32x4& s1) {
    u32x4 r; r.x = cvt_pk(s0[0], s0[1]); r.y = cvt_pk(s0[2], s0[3]); r.z = cvt_pk(s1[0], s1[1]); r.w = cvt_pk(s1[2], s1[3]); return __builtin_bit_cast(bf16x8, r);
}
#define MFMA16(a, b, c) __builtin_amdgcn_mfma_f32_16x16x32_bf16(a, b, c, 0, 0, 0)
#define SCHED_FENCE() __builtin_amdgcn_sched_barrier(0)
#define RET_QS(AF_EXPR)                                                                                                      \
    {                                                                                                                         \
        bf16x8 qb[2][4];                                                                                                      \
        _Pragma("unroll") for (int ib = 0; ib < 4; ++ib) { const LAS unsigned char* qp = lds + R_QS + (ib * 16 + fr) * R_ROW + (4 * fq) * 2; qb[0][ib] = ld2x64(qp, qp + 32); } \
        _Pragma("unroll") for (int kq = 0; kq < 8; ++kq) {                                                                    \
            if (kq < 7) { _Pragma("unroll") for (int ib = 0; ib < 4; ++ib) { const LAS unsigned char* qp = lds + R_QS + (ib * 16 + fr) * R_ROW + (32 * (kq + 1) + 4 * fq) * 2; qb[(kq + 1) & 1][ib] = ld2x64(qp, qp + 32); } } \
            const bf16x8 af = (AF_EXPR);                                                                                      \
            SCHED_FENCE();                                                                                                    \
            _Pragma("unroll") for (int ib = 0; ib < 4; ++ib) aQ[ib] = MFMA16(af, qb[kq & 1][ib], aQ[ib]);                     \
            SCHED_FENCE();                                                                                                    \
        }                                                                                                                     \
    }
#define RSRC(p) __builtin_amdgcn_make_buffer_rsrc((void*)(p), (short)0, 0x7fffffff, 0x00020000)
#define BLD128(r, vo, so) __builtin_bit_cast(u32x4, __builtin_amdgcn_raw_buffer_load_b128(r, vo, so, 0))
#define BLD64(r, vo, so) __builtin_bit_cast(u32x2, __builtin_amdgcn_raw_buffer_load_b64(r, vo, so, 0))
#define BST64(v, r, vo, so) __builtin_amdgcn_raw_buffer_store_b64(__builtin_bit_cast(v2u_t, v), r, vo, so, 0)
typedef unsigned v2u_t __attribute__((__vector_size__(2 * sizeof(unsigned))));
template <int ABL> __device__ __forceinline__ void ret_pass1(Frame& F) {
    LAS unsigned char* lds = F.lds;
    const int tid = F.tid, lane = F.lane, w = F.wave, fr = lane & 15, fq = lane >> 4;
    const int srow = tid >> 5, sc16 = tid & 31, vrow = tid >> 4, vc = tid & 15;
    const int sib = w >> 1, sil = sib * 16 + fr, jb0 = (w & 1) * 2, q4 = fr >> 2, p4 = fr & 3;
    float* Lw = (float*)F.out;
    for (int item = F.vcu; item < 256; item += F.G) {
        const int slice = item & 3, seg = (item >> 2) & 3, bh = item >> 4, b = bh >> 2, h = bh & 3;
        const float l2g = log2f(1.0f - exp2f(-5.0f - (float)h));
        const size_t tok0 = (size_t)b * SEQ + seg * 2048;
        const __amdgpu_buffer_rsrc_t Qg = RSRC(F.Q + tok0 * 1024 + h * 256), Kg = RSRC(F.K + tok0 * 1024 + h * 256), Vg = RSRC(F.V + tok0 * 2048 + h * 512 + slice * 128);
        unsigned oq[4], ov[2], oo4[4];
#pragma unroll
        for (int i = 0; i < 4; ++i) { oq[i] = (unsigned)((srow + 16 * i) * 2048 + sc16 * 16); oo4[i] = (unsigned)((i * 16 + fr) * 4096 + (16 * w + 4 * fq) * 2); }
#pragma unroll
        for (int i = 0; i < 2; ++i) ov[i] = (unsigned)((vrow + 32 * i) * 4096 + vc * 16);
        const float zeta0 = exp2f((float)(63 - vrow) * l2g), zeta1 = exp2f((float)(31 - vrow) * l2g), gC = exp2f(64.0f * l2g);
        float rs1[4], xi[4];
#pragma unroll
        for (int ib = 0; ib < 4; ++ib) { rs1[ib] = exp2f((float)(ib * 16 + fr - 63) * l2g); xi[ib] = exp2f((float)(ib * 16 + fr + 1) * l2g); }
        f32x4 S[16];
#pragma unroll
        for (int i = 0; i < 16; ++i) S[i] = (f32x4){0.f, 0.f, 0.f, 0.f};
        u32x4 pq[4], pk[4], pv[2]; u32x2 ost[4];
#pragma unroll
        for (int i = 0; i < 4; ++i) { pq[i] = BLD128(Qg, oq[i], 0); pk[i] = BLD128(Kg, oq[i], 0); ost[i] = (u32x2){0u, 0u}; }
#pragma unroll
        for (int i = 0; i < 2; ++i) pv[i] = BLD128(Vg, ov[i], 0);
        for (int n = 0; n < 32; ++n) {
            if (!(ABL & 8) || n == 0) {
#pragma unroll
            for (int i = 0; i < 4; ++i) { *(LAS u32x4*)(lds + R_QS + (srow + 16 * i) * R_ROW + sc16 * 16) = pq[i]; *(LAS u32x4*)(lds + R_KS + (srow + 16 * i) * R_ROW + sc16 * 16) = pk[i]; }
#pragma unroll
            for (int i = 0; i < 2; ++i) { const float z = i ? zeta1 : zeta0; u32x4 o;
                o.x = cvt_pk(bf_lo(pv[i].x) * z, bf_hi(pv[i].x) * z); o.y = cvt_pk(bf_lo(pv[i].y) * z, bf_hi(pv[i].y) * z); o.z = cvt_pk(bf_lo(pv[i].z) * z, bf_hi(pv[i].z) * z); o.w = cvt_pk(bf_lo(pv[i].w) * z, bf_hi(pv[i].w) * z);
                *(LAS u32x4*)(lds + R_VZ + (vrow + 32 * i) * R_VROW + vc * 16) = o; }
            } else { asm volatile("" :: "v"(pq[0]), "v"(pq[1]), "v"(pq[2]), "v"(pq[3]), "v"(pk[0]), "v"(pk[1]), "v"(pk[2]), "v"(pk[3]), "v"(pv[0]), "v"(pv[1])); }
            RAW_BAR();
            if (n > 0) {
#pragma unroll
                for (int ib = 0; ib < 4; ++ib) BST64(ost[ib], Vg, oo4[ib], (n - 1) * (64 * 4096));
            }
            if (n + 1 < 32) {
#pragma unroll
                for (int i = 0; i < 4; ++i) { pq[i] = BLD128(Qg, oq[i], (n + 1) * (64 * 2048)); pk[i] = BLD128(Kg, oq[i], (n + 1) * (64 * 2048)); }
#pragma unroll
                for (int i = 0; i < 2; ++i) pv[i] = BLD128(Vg, ov[i], (n + 1) * (64 * 4096));
            }
            if (!(ABL & 1))
            {
                f32x4 s0 = (f32x4){0.f, 0.f, 0.f, 0.f}, s1 = (f32x4){0.f, 0.f, 0.f, 0.f};
                const LAS unsigned char* qrow = lds + R_QS + sil * R_ROW + fq * 16;
                const LAS unsigned char* krow = lds + R_KS + (jb0 * 16 + fr) * R_ROW + fq * 16;
                bf16x8 sq[2], sk0[2], sk1[2];
#pragma unroll
                for (int ks = 0; ks < 2; ++ks) { sq[ks] = ldfrag(qrow + ks * 64); sk0[ks] = ldfrag(krow + ks * 64); sk1[ks] = ldfrag(krow + 16 * R_ROW + ks * 64); }
#pragma unroll
                for (int ks = 0; ks < 8; ++ks) {
                    SCHED_FENCE();
                    s0 = MFMA16(sk0[ks & 1], sq[ks & 1], s0); s1 = MFMA16(sk1[ks & 1], sq[ks & 1], s1);
                    SCHED_FENCE();
                    if (ks + 2 < 8) { sq[ks & 1] = ldfrag(qrow + (ks + 2) * 64); sk0[ks & 1] = ldfrag(krow + (ks + 2) * 64); sk1[ks & 1] = ldfrag(krow + 16 * R_ROW + (ks + 2) * 64); }
                }
                const int j0 = jb0 * 16 + 4 * fq;
#pragma unroll
                for (int x = 0; x < 4; ++x) { if (j0 + x > sil) s0[x] = 0.f; if (j0 + 16 + x > sil) s1[x] = 0.f; }
                u32x2 p0, p1; p0.x = cvt_pk(s0[0], s0[1]); p0.y = cvt_pk(s0[2], s0[3]); p1.x = cvt_pk(s1[0], s1[1]); p1.y = cvt_pk(s1[2], s1[3]);
                *(LAS u32x2*)(lds + R_P + sil * R_PROW + j0 * 2) = p0; *(LAS u32x2*)(lds + R_P + sil * R_PROW + (j0 + 16) * 2) = p1;
            }
            RAW_BAR();
            bf16x8 vzf[2];
#pragma unroll
            for (int ks = 0; ks < 2; ++ks) vzf[ks] = ldtr2(lds + R_VZ + (32 * ks + 8 * fq + q4) * R_VROW + 32 * w + 8 * p4, 4 * R_VROW);
            f32x4 aP[4], aQ[4];
#pragma unroll
            for (int ib = 0; ib < 4; ++ib) { aP[ib] = (f32x4){0.f, 0.f, 0.f, 0.f}; aQ[ib] = (f32x4){0.f, 0.f, 0.f, 0.f}; }
            if (!(ABL & 2)) {
                bf16x8 pf[2][4];
#pragma unroll
                for (int ib = 0; ib < 4; ++ib) pf[0][ib] = ldfrag(lds + R_P + (ib * 16 + fr) * R_PROW + fq * 16);
#pragma unroll
                for (int ks = 0; ks < 2; ++ks) {
                    if (ks == 0) {
#pragma unroll
                        for (int ib = 0; ib < 4; ++ib) pf[1][ib] = ldfrag(lds + R_P + (ib * 16 + fr) * R_PROW + fq * 16 + 64);
                    }
                    SCHED_FENCE();
#pragma unroll
                    for (int ib = 0; ib < 4; ++ib) aP[ib] = MFMA16(vzf[ks], pf[ks][ib], aP[ib]);
                    SCHED_FENCE();
                }
            }
            if (!(ABL & 2)) RET_QS(state_frag(S[2 * kq], S[2 * kq + 1]))
#pragma unroll
            for (int ib = 0; ib < 4; ++ib) { ost[ib].x = cvt_pk(rs1[ib] * aP[ib][0] + xi[ib] * aQ[ib][0], rs1[ib] * aP[ib][1] + xi[ib] * aQ[ib][1]); ost[ib].y = cvt_pk(rs1[ib] * aP[ib][2] + xi[ib] * aQ[ib][2], rs1[ib] * aP[ib][3] + xi[ib] * aQ[ib][3]); }
#pragma unroll
            for (int db = 0; db < 16; ++db) S[db] = S[db] * gC;
            if (!(ABL & 4)) {
                bf16x8 kf[2][4];
                const LAS unsigned char* kb = lds + R_KS + (8 * fq + q4) * R_ROW + 8 * p4;
#pragma unroll
                for (int j = 0; j < 4; ++j) kf[0][j] = ldtr2(kb + 32 * j, 4 * R_ROW);
#pragma unroll
                for (int g = 0; g < 8; ++g) {
                    if (g < 7) {
#pragma unroll
                        for (int j = 0; j < 4; ++j) kf[(g + 1) & 1][j] = ldtr2(kb + 32 * ((g + 1) >> 2) * R_ROW + 32 * (4 * ((g + 1) & 3) + j), 4 * R_ROW);
                    }
                    SCHED_FENCE();
#pragma unroll
                    for (int j = 0; j < 4; ++j) S[4 * (g & 3) + j] = MFMA16(kf[g & 1][j], vzf[g >> 2], S[4 * (g & 3) + j]);
                    SCHED_FENCE();
                }
            }
            RAW_BAR();
        }
#pragma unroll
        for (int ib = 0; ib < 4; ++ib) BST64(ost[ib], Vg, oo4[ib], 31 * (64 * 4096));
        float* Lp = Lw + ((size_t)(item * 8 + w) * 16) * 256 + lane * 4;
#pragma unroll
        for (int db = 0; db < 16; ++db) *(f32x4*)(Lp + db * 256) = S[db];
    }
}
__device__ __forceinline__ void ret_pass2(Frame& F) {
    LAS unsigned char* lds = F.lds;
    const int tid = F.tid, lane = F.lane, w = F.wave, fr = lane & 15, fq = lane >> 4;
    const int srow = tid >> 5, sc16 = tid & 31;
    const float* Lw = (const float*)F.out;
    for (int u = F.vcu; u < 192; u += F.G) {
        const int it3 = u, slice = it3 & 3, sg = (it3 >> 2) % 3 + 1, bh = it3 / 12, b = bh >> 2, h = bh & 3;
        const float l2g = log2f(1.0f - exp2f(-5.0f - (float)h));
        const size_t tok0 = (size_t)b * SEQ + sg * 2048;
        const __amdgpu_buffer_rsrc_t Qg = RSRC(F.Q + tok0 * 1024 + h * 256), Vg = RSRC(F.V + tok0 * 2048 + h * 512 + slice * 128);
        unsigned oq[4], oo4[4];
#pragma unroll
        for (int i = 0; i < 4; ++i) { oq[i] = (unsigned)((srow + 16 * i) * 2048 + sc16 * 16); oo4[i] = (unsigned)((i * 16 + fr) * 4096 + (16 * w + 4 * fq) * 2); }
        f32x4 T[16];
#pragma unroll
        for (int i = 0; i < 16; ++i) T[i] = (f32x4){0.f, 0.f, 0.f, 0.f};
        for (int m = 0; m < sg; ++m) {
            const float coef = exp2f(2048.0f * (float)(sg - 1 - m) * l2g);
            const float* Lp = Lw + ((size_t)(((bh << 4) | (m << 2) | slice) * 8 + w) * 16) * 256 + lane * 4;
#pragma unroll
            for (int db = 0; db < 16; ++db) T[db] = T[db] + *(const f32x4*)(Lp + db * 256) * coef;
        }
        bf16x8 af8[8];
#pragma unroll
        for (int kq = 0; kq < 8; ++kq) af8[kq] = state_frag(T[2 * kq], T[2 * kq + 1]);
        const int n0 = 0, NCH = 32;
        u32x4 pq[4]; u32x2 res[4], oo[4];
#pragma unroll
        for (int i = 0; i < 4; ++i) { pq[i] = BLD128(Qg, oq[i], n0 * (64 * 2048)); res[i] = (u32x2){0u, 0u}; oo[i] = BLD64(Vg, oo4[i], n0 * (64 * 4096)); }
        for (int n = n0; n < n0 + NCH; ++n) {
#pragma unroll
            for (int i = 0; i < 4; ++i) *(LAS u32x4*)(lds + R_QS + (srow + 16 * i) * R_ROW + sc16 * 16) = pq[i];
            RAW_BAR();
            if (n > n0) {
#pragma unroll
                for (int ib = 0; ib < 4; ++ib) BST64(res[ib], Vg, oo4[ib], (n - 1) * (64 * 4096));
            }
            if (n + 1 < n0 + NCH) {
#pragma unroll
                for (int i = 0; i < 4; ++i) pq[i] = BLD128(Qg, oq[i], (n + 1) * (64 * 2048));
            }
            f32x4 aQ[4];
#pragma unroll
            for (int ib = 0; ib < 4; ++ib) aQ[ib] = (f32x4){0.f, 0.f, 0.f, 0.f};
            RET_QS(af8[kq])
#pragma unroll
            for (int ib = 0; ib < 4; ++ib) { const float x = exp2f((float)(n * 64 + ib * 16 + fr + 1) * l2g);
                res[ib].x = cvt_pk(bf_lo(oo[ib].x) + x * aQ[ib][0], bf_hi(oo[ib].x) + x * aQ[ib][1]); res[ib].y = cvt_pk(bf_lo(oo[ib].y) + x * aQ[ib][2], bf_hi(oo[ib].y) + x * aQ[ib][3]); }
            if (n + 1 < n0 + NCH) {
#pragma unroll
                for (int ib = 0; ib < 4; ++ib) oo[ib] = BLD64(Vg, oo4[ib], (n + 1) * (64 * 4096));
            }
            RAW_BAR();
        }
#pragma unroll
        for (int ib = 0; ib < 4; ++ib) BST64(res[ib], Vg, oo4[ib], (n0 + NCH - 1) * (64 * 4096));
    }
}
__device__ __forceinline__ void gn_pass(Frame& F, bool dry) {
    const int gw = F.vcu * 8 + F.wave, NGW = F.G * 8;
    for (int t0 = gw * 2; t0 < M; t0 += NGW * 2) {
        u32x4 o[8], z[8];
#pragma unroll
        for (int q = 0; q < 8; ++q) { const size_t off = (size_t)(t0 + (q >> 2)) * 2048 + (q & 3) * 512 + F.lane * 8; o[q] = *(const u32x4*)(F.V + off); z[q] = *(const u32x4*)(F.ZR + off); }
        float v[8][8], s[8];
#pragma unroll
        for (int q = 0; q < 8; ++q) { v[q][0] = bf_lo(o[q].x); v[q][1] = bf_hi(o[q].x); v[q][2] = bf_lo(o[q].y); v[q][3] = bf_hi(o[q].y); v[q][4] = bf_lo(o[q].z); v[q][5] = bf_hi(o[q].z); v[q][6] = bf_lo(o[q].w); v[q][7] = bf_hi(o[q].w);
            s[q] = ((v[q][0] + v[q][1]) + (v[q][2] + v[q][3])) + ((v[q][4] + v[q][5]) + (v[q][6] + v[q][7])); }
#pragma unroll
        for (int q = 0; q < 8; ++q) s[q] = wave_sum(s[q]) * (1.0f / 512.0f);
#pragma unroll
        for (int q = 0; q < 8; ++q) { float a = 0.f;
#pragma unroll
            for (int i = 0; i < 8; ++i) { v[q][i] -= s[q]; a += v[q][i] * v[q][i]; }
            s[q] = a; }
#pragma unroll
        for (int q = 0; q < 8; ++q) s[q] = rsqrtf(wave_sum(s[q]) * (1.0f / 512.0f) + 1e-5f);
#pragma unroll
        for (int q = 0; q < 8; ++q) { const size_t off = (size_t)(t0 + (q >> 2)) * 2048 + (q & 3) * 512 + F.lane * 8; const float rs = s[q];
            u32x4 r; r.x = cvt_pk(v[q][0] * rs * bf_lo(z[q].x), v[q][1] * rs * bf_hi(z[q].x)); r.y = cvt_pk(v[q][2] * rs * bf_lo(z[q].y), v[q][3] * rs * bf_hi(z[q].y));
            r.z = cvt_pk(v[q][4] * rs * bf_lo(z[q].z), v[q][5] * rs * bf_hi(z[q].z)); r.w = cvt_pk(v[q][6] * rs * bf_lo(z[q].w), v[q][7] * rs * bf_hi(z[q].w));
            if (dry) *(u32x4*)(F.H + (off & (size_t)(32u * 1024u * 1024u - 1u))) = r; else *(u32x4*)(F.ZR + off) = r; }
    }
}
__device__ __forceinline__ void conv_pass(Frame& F) {
    LAS float* cv = (LAS float*)F.lds;
    const int t = F.tid, c0 = 2 * t, lane = F.lane, w = F.wave;
    float w0[31], w1[31];
#pragma unroll
    for (int k = 0; k < 31; ++k) { const f32x2v wv = *(const f32x2v*)(F.conv_w + k * 1024 + c0); w0[k] = wv.x; w1[k] = wv.y; }
    const f32x2v cb = *(const f32x2v*)(F.conv_b + c0);
    const bf16* A = F.Q;
    const bf16* ZC = F.K;
    for (int tile = F.vcu; tile < M / 128; tile += F.G) {
        const int tok0 = tile * 128, b = tok0 / SEQ, s0 = tok0 % SEQ;
        const bf16* Ab = A + (size_t)b * SEQ * 1024 + c0;
        float in0[38], in1[38];
#pragma unroll
        for (int i = 0; i < 38; ++i) { const int s = s0 - 30 + i; const int sc = s < 0 ? 0 : s;
            unsigned uu = *(const unsigned*)(Ab + (size_t)sc * 1024); if (s < 0) uu = 0u; in0[i] = bf_lo(uu); in1[i] = bf_hi(uu); }
        for (int g32 = 0; g32 < 4; ++g32) {
            u32x2 zz[4][4];
#pragma unroll
            for (int q = 0; q < 4; ++q)
#pragma unroll
                for (int j = 0; j < 4; ++j) zz[q][j] = *(const u32x2*)(ZC + (size_t)(tok0 + 32 * g32 + 4 * w + q) * 1024 + 4 * lane + 256 * j);
            for (int sub = 0; sub < 4; ++sub) {
                const int gi = 4 * g32 + sub, sf = s0 + 8 * gi;
                unsigned nx[8];
#pragma unroll
                for (int i = 0; i < 8; ++i) { const int sn = (gi < 15) ? sf + 8 + i : sf + i; nx[i] = *(const unsigned*)(Ab + (size_t)sn * 1024); }
#pragma unroll
                for (int j = 0; j < 8; ++j) { float x0 = cb.x, x1 = cb.y;
#pragma unroll
                    for (int k = 0; k < 31; ++k) { x0 = fmaf(w0[k], in0[j + k], x0); x1 = fmaf(w1[k], in1[j + k], x1); }
                    *(LAS f32x2v*)(cv + (8 * sub + j) * 1024 + c0) = (f32x2v){x0, x1}; }
#pragma unroll
                for (int i = 0; i < 30; ++i) { in0[i] = in0[i + 8]; in1[i] = in1[i + 8]; }
#pragma unroll
                for (int i = 0; i < 8; ++i) { in0[30 + i] = bf_lo(nx[i]); in1[30 + i] = bf_hi(nx[i]); }
            }
            RAW_BAR();
#pragma unroll
            for (int q = 0; q < 4; ++q) {
                const int tk = 4 * w + q;
                f32x4 v[4]; float s = 0.f, s2 = 0.f;
#pragma unroll
                for (int j = 0; j < 4; ++j) { v[j] = *(const LAS f32x4*)(cv + tk * 1024 + 4 * lane + 256 * j); s += (v[j][0] + v[j][1]) + (v[j][2] + v[j][3]); }
                const float mean = wave_sum(s) * (1.0f / 1024.0f);
#pragma unroll
                for (int j = 0; j < 4; ++j) { v[j] = v[j] - mean; s2 += (v[j][0] * v[j][0] + v[j][1] * v[j][1]) + (v[j][2] * v[j][2] + v[j][3] * v[j][3]); }
                const float rstd = rsqrtf(wave_sum(s2) * (1.0f / 1024.0f) + 1e-5f);
                bf16* orow = F.H + (size_t)(tok0 + 32 * g32 + tk) * 1024 + 4 * lane;
#pragma unroll
                for (int j = 0; j < 4; ++j) { const f32x4 lg = *(const f32x4*)(F.ln_g + 4 * lane + 256 * j), lb = *(const f32x4*)(F.ln_b + 4 * lane + 256 * j);
                    const f32x4 y = v[j] * rstd * lg + lb;
                    u32x2 o; o.x = cvt_pk(fsilu(y[0]) * bf_lo(zz[q][j].x), fsilu(y[1]) * bf_hi(zz[q][j].x)); o.y = cvt_pk(fsilu(y[2]) * bf_lo(zz[q][j].y), fsilu(y[3]) * bf_hi(zz[q][j].y));
                    *(u32x2*)(orow + 256 * j) = o; }
            }
            RAW_BAR();
        }
    }
    __syncthreads();
}
__device__ __forceinline__ void phase8(Frame& F) {
    const int gw = F.vcu * 8 + F.wave, NGW = F.G * 8;
    for (int rb = gw; rb < M / 16; rb += NGW) {
        const int b = (rb * 16) / SEQ;
        f32x4 cg[4];
#pragma unroll
        for (int j = 0; j < 4; ++j) { const int col = 4 * F.lane + 256 * j; cg[j] = *(const f32x4*)(F.post_g + col) * *(const f32x4*)(F.mod + b * 3072 + 2048 + col); }
        for (int r = 0; r < 16; r += 2) {
            const size_t m = (size_t)rb * 16 + r;
            f32x4 v[2][4], xv[2][4]; float ss[2];
#pragma unroll
            for (int q = 0; q < 2; ++q) { const u32x2* yr = (const u32x2*)(F.YB + (m + q) * D) + F.lane; const f32x4* xr = (const f32x4*)(F.x + (m + q) * D) + F.lane;
#pragma unroll
                for (int j = 0; j < 4; ++j) { const u32x2 yy = yr[64 * j]; v[q][j] = (f32x4){bf_lo(yy.x), bf_hi(yy.x), bf_lo(yy.y), bf_hi(yy.y)}; xv[q][j] = xr[64 * j]; } }
#pragma unroll
            for (int q = 0; q < 2; ++q) { float s = 0.f;
#pragma unroll
                for (int j = 0; j < 4; ++j) s += (v[q][j][0] * v[q][j][0] + v[q][j][1] * v[q][j][1]) + (v[q][j][2] * v[q][j][2] + v[q][j][3] * v[q][j][3]);
                ss[q] = s; }
#pragma unroll
            for (int q = 0; q < 2; ++q) ss[q] = wave_sum(ss[q]);
#pragma unroll
            for (int q = 0; q < 2; ++q) { const float rstd = rsqrtf(ss[q] * (1.0f / D) + 1e-6f);
                f32x4* orow = (f32x4*)(F.out + (m + q) * D) + F.lane;
#pragma unroll
                for (int j = 0; j < 4; ++j) orow[64 * j] = xv[q][j] + v[q][j] * rstd * cg[j]; }
        }
    }
}

struct Args { const float* in[15]; float* out; unsigned char* ws; int ph_lo, ph_hi; };
#ifndef MK_TWICE
#define MK_TWICE 0
#endif
#define REP(k) for (int rep_ = ((MK_TWICE >> (k)) & 1); rep_ >= 0; --rep_)
#define DRY ((bool)(rep_ > 0))
__global__ void __launch_bounds__(512, 2) mk_fwd(Args args) {
    extern __shared__ __attribute__((aligned(16))) unsigned char lds_raw[];
    Frame F;
    F.lds = (LAS unsigned char*)lds_raw;
    F.MISC = (volatile LAS unsigned*)(F.lds + MISC_OFF);
    F.tid = threadIdx.x; F.lane = F.tid & 63; F.wave = __builtin_amdgcn_readfirstlane(F.tid >> 6);
    F.G = gridDim.x; { const int bx = blockIdx.x; F.vcu = (F.G % 8 == 0) ? (bx % 8) * (F.G / 8) + bx / 8 : bx; }
    unsigned char* ws = args.ws;
    F.ctl = (unsigned*)(ws + WS_CTL);
    F.x = args.in[0]; F.c = args.in[1]; F.pos = (const int*)args.in[2]; F.w_ada = args.in[3]; F.b_ada = args.in[4]; F.pre_g = args.in[5]; F.w_in = args.in[6];
    F.conv_w = args.in[7]; F.conv_b = args.in[8]; F.ln_g = args.in[9]; F.ln_b = args.in[10]; F.w_ret = args.in[11]; F.w_conv = args.in[12]; F.w_out = args.in[13]; F.post_g = args.in[14];
    F.out = args.out; F.mod = (float*)(ws + WS_MOD);
    F.WIN = (bf16*)(ws + WS_WIN); F.WRET = (bf16*)(ws + WS_WRET); F.WCONV = (bf16*)(ws + WS_WCONV); F.WOUT = (bf16*)(ws + WS_WOUT);
    F.H = (bf16*)(ws + WS_H); F.Q = (bf16*)(ws + WS_Q); F.K = (bf16*)(ws + WS_K); F.V = (bf16*)(ws + WS_V); F.ZR = (bf16*)(ws + WS_ZR);
    F.SGA = (bf16*)args.out; F.SGB = (bf16*)args.out + (size_t)M * 1024; F.F32S = (float*)(ws + WS_V); F.YB = (bf16*)(ws + WS_K);
    for (int u = F.tid; u < (LDS_BYTES - LDSCTL_OFF) / 4; u += 512) ((LAS unsigned*)(F.lds + LDSCTL_OFF))[u] = 0u;
    __syncthreads();
    const int lo = args.ph_lo, hi = args.ph_hi;
    XcdBarrier bar; bar.bar = (unsigned*)(F.ctl + CW_BAR); bar.x = 0; bar.st = nullptr;
    if (hi - lo > 1) bar = xcd_barrier_post((unsigned*)(F.ctl + CW_BAR), F.MISC + 8);
#define IN(k) (lo <= (k) && (k) < hi)
#define SEAM(k) do { if (IN(k) && IN((k) + 1)) xcd_barrier(bar); } while (0)
    if (IN(0)) { phase0(F); } SEAM(0);
    if (IN(1)) { phase1(F); } SEAM(1);
    if (IN(2)) {
        pg8::Gemm g{F.H, F.WIN, M, NT1 * 256, 1024}; pg8::StaticOrder S; S.init(M, NT1 * 256, F.G, (int)blockIdx.x);
        EpiProj1 E{F.Q, F.K, F.V, F.ZR, F.pos};
        pg8::gemm_phase<EpiProj1, pg8::StaticOrder, true, true>(F.lds, g, S, E);
    } SEAM(2);
    if (IN(3)) { ret_pass1<0>(F); } SEAM(3);
    if (IN(4)) { ret_pass2(F); } SEAM(4);
    if (IN(5)) {
        pg8::Gemm g{F.H, F.WIN + (size_t)NT1 * 256 * 1024, M, NT2 * 256, 1024}; pg8::StaticOrder S; S.init(M, NT2 * 256, F.G, (int)blockIdx.x);
        EpiProj2 E{F.Q, F.K, F.SGA, F.SGB};
        pg8::gemm_phase<EpiProj2, pg8::StaticOrder, true, true>(F.lds, g, S, E);
    } SEAM(5);
    if (IN(6)) { gn_pass(F, false); conv_pass(F); } SEAM(6);
    if (IN(7)) {
        pg8::StaticOrder S; S.init(M, 1024, F.G, (int)blockIdx.x);
        pg8::Gemm2 g{F.ZR, F.WRET, 2048, F.H, F.WCONV, 1024, M, 1024}; EpiMerge E{F.SGA, F.SGB, F.Q};
        pg8::gemm_phase2<EpiMerge, pg8::StaticOrder>(F.lds, g, S, E);
    } SEAM(7);
    if (IN(8)) {
        pg8::Gemm g{F.Q, F.WOUT, M, 1024, 1024}; pg8::StaticOrder S; S.init(M, 1024, F.G, (int)blockIdx.x);
        EpiY E{F.YB};
        pg8::gemm_phase<EpiY, pg8::StaticOrder, true, true>(F.lds, g, S, E);
    } SEAM(8);
    if (IN(9)) { phase8(F); }
#ifdef MK_ABL
    if (IN(10)) { ret_pass1<MK_ABL>(F); }
#endif
#undef IN
#undef SEAM
}


__global__ void mk_dump(const unsigned char* ws, float* out, int which) {
    const size_t i = (size_t)blockIdx.x * blockDim.x + threadIdx.x;
    if (i >= (size_t)M * 1024) return;
    const size_t m = i >> 10, c = i & 1023;
    const bf16* Q = (const bf16*)(ws + WS_Q); const bf16* K = (const bf16*)(ws + WS_K); const bf16* V = (const bf16*)(ws + WS_V); const bf16* ZR = (const bf16*)(ws + WS_ZR); const bf16* H = (const bf16*)(ws + WS_H);
    float r = 0.f;
    auto f = [](bf16 v) { return __uint_as_float(((unsigned)v) << 16); };
    if (which == 0) r = f(H[i]);
    if (which == 1) r = f(Q[i]) + f(K[i]) + f(V[m * 2048 + c]) + f(V[m * 2048 + 1024 + c]) + f(ZR[m * 2048 + c]) + f(ZR[m * 2048 + 1024 + c]);
    if (which == 2) r = f(V[m * 2048 + c]) + f(V[m * 2048 + 1024 + c]);
    if (which == 3) r = f(Q[i]) + f(K[i]);
    if (which == 4) r = f(K[i]) + f(ZR[m * 2048 + c]) + f(ZR[m * 2048 + 1024 + c]);
    if (which == 5) r = f(H[i]);
    if (which == 6) r = ((const float*)(ws + WS_V))[i];
    out[i] = r;
}
#ifndef MK_SPLIT
#define MK_SPLIT 0
#endif
extern "C" void kernel_launch(void* const* d_in, const int* in_sizes, int n_in, void* d_out, int out_size, void* d_ws, size_t ws_size, hipStream_t stream) {
    static int grid = 0;
    if (grid == 0) {
        if (n_in != 15 || in_sizes[0] != M * D || out_size != M * D || ws_size < WS_END) { fprintf(stderr, "kernel_launch: unexpected shapes (n_in %d, in0 %d, out %d, ws %zu)\n", n_in, n_in > 0 ? in_sizes[0] : -1, out_size, ws_size); grid = -1; return; }
        int dev = 0, cus = 0;
        if (hipGetDevice(&dev) != hipSuccess || hipDeviceGetAttribute(&cus, hipDeviceAttributeMultiprocessorCount, dev) != hipSuccess) { grid = -1; return; }
        if (hipFuncSetAttribute((const void*)mk_fwd, hipFuncAttributeMaxDynamicSharedMemorySize, LDS_BYTES) != hipSuccess) { fprintf(stderr, "kernel_launch: hipFuncSetAttribute failed\n"); grid = -1; return; }
        grid = cus;
    }
    if (grid < 0) return;
    (void)hipMemsetAsync((char*)d_ws + WS_CTL, 0, CTL_BYTES, stream);
    Args a{};
    for (int i = 0; i < 15; ++i) a.in[i] = (const float*)d_in[i];
    a.out = (float*)d_out; a.ws = (unsigned char*)d_ws;
#if MK_SPLIT
#ifdef MK_DUMP_AFTER
    for (int p = 0; p <= MK_DUMP_AFTER; ++p) { a.ph_lo = p; a.ph_hi = p + 1; hipLaunchKernelGGL(mk_fwd, dim3(grid), dim3(512), LDS_BYTES, stream, a); }
    hipLaunchKernelGGL(mk_dump, dim3(M * 1024 / 256), dim3(256), 0, stream, (const unsigned char*)d_ws, (float*)d_out, MK_DUMP_WHICH);
#else
    for (int p = 0; p < NPHASE; ++p) { a.ph_lo = p; a.ph_hi = p + 1; hipLaunchKernelGGL(mk_fwd, dim3(grid), dim3(512), LDS_BYTES, stream, a); }
#endif
#else
#ifdef MK_PRE_LO
    a.ph_lo = MK_PRE_LO; a.ph_hi = MK_PRE_HI; hipLaunchKernelGGL(mk_fwd, dim3(grid), dim3(512), LDS_BYTES, stream, a);
#endif
    a.ph_lo = 0; a.ph_hi = NPHASE; hipLaunchKernelGGL(mk_fwd, dim3(grid), dim3(512), LDS_BYTES, stream, a);
#ifdef MK_EXTRA_LO
    a.ph_lo = MK_EXTRA_LO; a.ph_hi = MK_EXTRA_HI; hipLaunchKernelGGL(mk_fwd, dim3(grid), dim3(512), LDS_BYTES, stream, a);
#endif
#endif
}
```

```cpp
#include <hip/hip_runtime.h>
#include <cstdio>
#include <cstdint>
namespace pg8 {
#define PG8_LAS __attribute__((address_space(3)))
typedef unsigned short bf16_t;
typedef short bf16x8 __attribute__((ext_vector_type(8)));
typedef float f32x4 __attribute__((ext_vector_type(4)));
typedef unsigned u32x4 __attribute__((ext_vector_type(4)));
constexpr int BM = 256, BK = 64, HALF = 128, HTB = HALF * BK * 2  , STAGE_BYTES = 8 * HTB, NXCD = 8, WGM = 8;

__host__ __device__ __forceinline__ int lds_byte(int r, int c) { const int st = (r >> 4) * 2 + (c >> 5), rr = r & 15, cc = c & 31, ob = rr * 64 + cc * 2; return st * 1024 + (ob ^ (((ob >> 9) & 1) << 5)); }
__host__ __device__ __forceinline__ void stage_rc(int b, int& R, int& C) { const int st = b / 1024, sb = b % 1024, swz = sb ^ (((sb >> 9) & 1) << 5); R = (st >> 1) * 16 + swz / 64; C = (st & 1) * 32 + (swz % 64) / 2; }
__host__ __device__ __forceinline__ int perm32(int rho) { const int n = rho >> 4, i = rho & 15; return 8 * (i >> 2) + 4 * n + (i & 3); }

struct Unit { int pm, pn; };
struct Gemm { const bf16_t* A; const bf16_t* Bt; int M, N, K; };

struct StaticOrder {
    int nM, nN, nwg, G, c;
    __host__ __device__ void init(int M, int N, int G_, int c_) { nM = M / BM; nN = N / BM; nwg = nM * nN; G = G_; c = c_; }
    __host__ __device__ bool next(int i, Unit& u) const {
        const long L = (long)i * G + c; if (L >= nwg) return false;
        int wgid = (int)L; { const int q = nwg / NXCD, r = nwg % NXCD, xcd = wgid % NXCD, off = wgid / NXCD; wgid = (xcd < r ? xcd * (q + 1) : r * (q + 1) + (xcd - r) * q) + off; }
        const int nig = WGM * nN, gid = wgid / nig, fm = gid * WGM, gsz = (nM - fm) < WGM ? (nM - fm) : WGM;
        u.pm = fm + ((wgid % nig) % gsz); u.pn = (wgid % nig) / gsz; return true;
    }
    __device__ __forceinline__ void a_ready(const Unit&) const {}
    __device__ __forceinline__ void done(const Unit&) const {}
};
__device__ __forceinline__ unsigned cvt_pk_bf16(float lo, float hi) { unsigned r; asm volatile("v_cvt_pk_bf16_f32 %0, %1, %2" : "=v"(r) : "v"(lo), "v"(hi)); return r; }
template <class Epi, class Sched, bool ALIGN_EPI = false, bool SP2 = false>
__device__ __forceinline__ void gemm_phase(PG8_LAS unsigned char* lds, const Gemm g, const Sched& S, const Epi& E) {
    const int tid = threadIdx.x, wid = __builtin_amdgcn_readfirstlane(tid >> 6), lane = tid & 63, wr = wid >> 2, wc = wid & 3, fr = lane & 15, fq = lane >> 4;
    const int K = g.K, nt = K / BK;
    unsigned voffA[2], voffB[2];
#pragma unroll
    for (int i = 0; i < 2; ++i) { int R, C; stage_rc(tid * 16 + i * 8192, R, C); const int Rb = 64 * (R >> 5) + perm32(R & 31);
        voffA[i] = (unsigned)(R * K + C) * 2u; voffB[i] = (unsigned)(Rb * K + C) * 2u; }
    const size_t kstep = (size_t)(BK * 2);
    const size_t hstep = (size_t)HALF * K * 2;
    const size_t hstepB = (size_t)32 * K * 2;
    const size_t tstep = 2 * hstep;
    const unsigned ldsw = (unsigned)wid * 1024u;
    const int aoff = lds_byte(wr * 64 + fr, fq * 8), boff = lds_byte(wc * 32 + fr, fq * 8);
#define PG8_SA(b, h) (((b) * 2 + (h)) * HTB)
#define PG8_SB(b, h) ((4 + (b) * 2 + (h)) * HTB)
#define PG8_STAGE(bufoff, gbase, voff) do { _Pragma("unroll") for (int _i = 0; _i < 2; ++_i) \
        __builtin_amdgcn_global_load_lds((const unsigned*)((const char*)(gbase) + (voff)[_i]), (PG8_LAS unsigned*)(lds + (bufoff) + ldsw + _i * 8192), 16, 0, 0); } while (0)
#define PG8_LDA(dst, b, h) do { _Pragma("unroll") for (int m = 0; m < 4; ++m) _Pragma("unroll") for (int k = 0; k < 2; ++k) dst[m][k] = *(const PG8_LAS bf16x8*)(lds + PG8_SA(b, h) + aoff + m * 2048 + k * 1024); } while (0)
#define PG8_LDB(dst, b, h) do { _Pragma("unroll") for (int n = 0; n < 2; ++n) _Pragma("unroll") for (int k = 0; k < 2; ++k) dst[n][k] = *(const PG8_LAS bf16x8*)(lds + PG8_SB(b, h) + boff + n * 2048 + k * 1024); } while (0)
#define PG8_MMA(ai, bj, At, Bt) do { __builtin_amdgcn_s_setprio(1); _Pragma("unroll") for (int m = 0; m < 4; ++m) _Pragma("unroll") for (int n = 0; n < 2; ++n) _Pragma("unroll") for (int k = 0; k < 2; ++k) \
        acc[ai][bj][m][n] = __builtin_amdgcn_mfma_f32_16x16x32_bf16(Bt[n][k], At[m][k], acc[ai][bj][m][n], 0, 0, 0); __builtin_amdgcn_s_setprio(0); } while (0)
#define PG8_WAIT_V(n) asm volatile("s_waitcnt vmcnt(" #n ")" ::: "memory")
#define PG8_WAIT_L(n) asm volatile("s_waitcnt lgkmcnt(" #n ")" ::: "memory")
#define PG8_BAR __builtin_amdgcn_s_barrier()
#define PG8_SCHED __builtin_amdgcn_sched_barrier(0)
    Unit cur, nxt; int ui = 0;
    if (!S.next(0, cur)) return;
    f32x4 acc[2][2][4][2];
#pragma unroll
    for (int a = 0; a < 2; ++a)
#pragma unroll
        for (int b = 0; b < 2; ++b)
#pragma unroll
            for (int m = 0; m < 4; ++m)
#pragma unroll
                for (int n = 0; n < 2; ++n) acc[a][b][m][n] = (f32x4){0.f, 0.f, 0.f, 0.f};
    bf16x8 At[4][2], B0[2][2], B1[2][2];
    const char* cA = (const char*)g.A + (size_t)cur.pm * tstep; const char* cB = (const char*)g.Bt + (size_t)cur.pn * tstep;
    S.a_ready(cur);
    if constexpr (SP2) {
        PG8_STAGE(PG8_SB(0, 0), cB, voffB); PG8_STAGE(PG8_SB(0, 1), cB + hstepB, voffB); PG8_STAGE(PG8_SA(0, 0), cA, voffA); PG8_STAGE(PG8_SA(0, 1), cA + hstep, voffA);
        if (wr == 1) PG8_BAR;
        PG8_WAIT_V(2); PG8_BAR;
        PG8_STAGE(PG8_SB(1, 0), cB + kstep, voffB); PG8_STAGE(PG8_SA(1, 0), cA + kstep, voffA); PG8_STAGE(PG8_SB(1, 1), cB + hstepB + kstep, voffB);
        PG8_WAIT_V(6); PG8_BAR;
    } else {
        PG8_STAGE(PG8_SB(0, 0), cB, voffB); PG8_STAGE(PG8_SA(0, 0), cA, voffA); PG8_STAGE(PG8_SB(0, 1), cB + hstepB, voffB); PG8_STAGE(PG8_SA(0, 1), cA + hstep, voffA);
        if (wr == 1) PG8_BAR;
        PG8_WAIT_V(4); PG8_BAR;
        PG8_STAGE(PG8_SB(1, 0), cB + kstep, voffB); PG8_STAGE(PG8_SA(1, 0), cA + kstep, voffA); PG8_STAGE(PG8_SB(1, 1), cB + hstepB + kstep, voffB);
        PG8_WAIT_V(6); PG8_BAR;
    }
    for (;;) {
        const bool has_next = S.next(ui + 1, nxt);
        const char* nA = has_next ? (const char*)g.A + (size_t)nxt.pm * tstep : cA; const char* nB = has_next ? (const char*)g.Bt + (size_t)nxt.pn * tstep : cB;
        for (int t = 0; t < nt; t += 2) {
            const bool last = (t == nt - 2);
            const char* a1 = cA + (size_t)(t + 1) * kstep;
            const char* a2 = last ? nA : cA + (size_t)(t + 2) * kstep; const char* b2 = last ? nB : cB + (size_t)(t + 2) * kstep;
            const char* a3 = a2 + kstep; const char* b3 = b2 + kstep;
            if (last && has_next) S.a_ready(nxt);
            if constexpr (SP2) {
            PG8_LDB(B0, 0, 0); PG8_LDB(B1, 0, 1); PG8_SCHED; PG8_LDA(At, 0, 0); PG8_STAGE(PG8_SA(1, 1), a1 + hstep, voffA);
            PG8_WAIT_V(8); PG8_WAIT_L(0); PG8_BAR; PG8_MMA(0, 0, At, B0); PG8_MMA(0, 1, At, B1); PG8_BAR; PG8_SCHED;
            PG8_LDA(At, 0, 1); PG8_STAGE(PG8_SB(0, 0), b2, voffB); PG8_STAGE(PG8_SB(0, 1), b2 + hstepB, voffB); PG8_STAGE(PG8_SA(0, 0), a2, voffA);
            PG8_WAIT_V(8); PG8_WAIT_L(0); PG8_BAR; PG8_MMA(1, 0, At, B0); PG8_MMA(1, 1, At, B1); PG8_BAR; PG8_SCHED;
            PG8_LDB(B0, 1, 0); PG8_LDB(B1, 1, 1); PG8_SCHED; PG8_LDA(At, 1, 0); PG8_STAGE(PG8_SA(0, 1), a2 + hstep, voffA);
            PG8_WAIT_V(8); PG8_WAIT_L(0); PG8_BAR; PG8_MMA(0, 0, At, B0); PG8_MMA(0, 1, At, B1); PG8_BAR; PG8_SCHED;
            PG8_LDA(At, 1, 1); PG8_STAGE(PG8_SB(1, 0), b3, voffB); PG8_STAGE(PG8_SB(1, 1), b3 + hstepB, voffB); PG8_STAGE(PG8_SA(1, 0), a3, voffA);
            PG8_WAIT_V(8); PG8_WAIT_L(0); PG8_BAR; PG8_MMA(1, 0, At, B0); PG8_MMA(1, 1, At, B1); PG8_BAR; PG8_SCHED;
            } else {
            PG8_LDB(B0, 0, 0); PG8_SCHED; PG8_LDA(At, 0, 0); PG8_STAGE(PG8_SA(1, 1), a1 + hstep, voffA);
            PG8_WAIT_L(8); PG8_BAR; PG8_WAIT_L(0); PG8_MMA(0, 0, At, B0); PG8_BAR; PG8_SCHED;
            PG8_LDB(B1, 0, 1); PG8_STAGE(PG8_SB(0, 0), b2, voffB);
            PG8_BAR; PG8_WAIT_L(0); PG8_MMA(0, 1, At, B1); PG8_BAR;
            PG8_LDA(At, 0, 1); PG8_STAGE(PG8_SA(0, 0), a2, voffA);
            PG8_BAR; PG8_WAIT_L(0); PG8_MMA(1, 0, At, B0); PG8_BAR; PG8_SCHED;
            PG8_STAGE(PG8_SB(0, 1), b2 + hstepB, voffB);
            PG8_WAIT_V(6); PG8_BAR; PG8_MMA(1, 1, At, B1); PG8_BAR;
            PG8_LDB(B0, 1, 0); PG8_SCHED; PG8_LDA(At, 1, 0); PG8_STAGE(PG8_SA(0, 1), a2 + hstep, voffA);
            PG8_WAIT_L(8); PG8_BAR; PG8_WAIT_L(0); PG8_MMA(0, 0, At, B0); PG8_BAR; PG8_SCHED;
            PG8_LDB(B1, 1, 1); PG8_STAGE(PG8_SB(1, 0), b3, voffB);
            PG8_BAR; PG8_WAIT_L(0); PG8_MMA(0, 1, At, B1); PG8_BAR;
            PG8_LDA(At, 1, 1); PG8_STAGE(PG8_SA(1, 0), a3, voffA);
            PG8_BAR; PG8_WAIT_L(0); PG8_MMA(1, 0, At, B0); PG8_BAR; PG8_SCHED;
            PG8_STAGE(PG8_SB(1, 1), b3 + hstepB, voffB);
            PG8_WAIT_V(6); PG8_BAR; PG8_MMA(1, 1, At, B1); PG8_BAR;
            }
        }
        if constexpr (ALIGN_EPI) { if (wr == 0) PG8_BAR; }
        if constexpr (!Epi::AFTER_DRAIN) { E(acc, cur, wr, wc, fr, fq); S.done(cur); }
        if (!has_next) break;
#pragma unroll
        for (int a = 0; a < 2; ++a)
#pragma unroll
            for (int b = 0; b < 2; ++b)
#pragma unroll
                for (int m = 0; m < 4; ++m)
#pragma unroll
                    for (int n = 0; n < 2; ++n) acc[a][b][m][n] = (f32x4){0.f, 0.f, 0.f, 0.f};
        cur = nxt; cA = nA; cB = nB; ++ui;
        if constexpr (ALIGN_EPI) { if (wr == 1) PG8_BAR; }
    }
    PG8_WAIT_V(0);
    if constexpr (!ALIGN_EPI) { if (wr == 0) PG8_BAR; }
    PG8_BAR;
    if constexpr (Epi::AFTER_DRAIN) { E.fused(acc, cur, wr, wc, fr, fq, lds, wid, lane); S.done(cur); }
#undef PG8_SA
#undef PG8_SB
#undef PG8_STAGE
#undef PG8_LDA
#undef PG8_LDB
#undef PG8_MMA
#undef PG8_WAIT_V
#undef PG8_WAIT_L
#undef PG8_BAR
#undef PG8_SCHED
}
}
namespace pg8 {
struct Gemm2 { const bf16_t* A1; const bf16_t* B1t; int K1; const bf16_t* A2; const bf16_t* B2t; int K2; int M, N; };
template <class Epi, class Sched>
__device__ __forceinline__ void gemm_phase2(PG8_LAS unsigned char* lds, const Gemm2 g, const Sched& S, const Epi& E) {
    const int tid = threadIdx.x, wid = __builtin_amdgcn_readfirstlane(tid >> 6), lane = tid & 63, wr = wid >> 2, wc = wid & 3, fr = lane & 15, fq = lane >> 4;
    const int nt1 = g.K1 / BK, nt = nt1 + g.K2 / BK;
    unsigned rA2[2], rB2[2], c2[2];
#pragma unroll
    for (int i = 0; i < 2; ++i) { int R, C; stage_rc(tid * 16 + i * 8192, R, C); const int Rb = 64 * (R >> 5) + perm32(R & 31);
        rA2[i] = (unsigned)R * 2u; rB2[i] = (unsigned)Rb * 2u; c2[i] = (unsigned)C * 2u; }

    const size_t kstep = (size_t)(BK * 2);
    const size_t hstep1 = (size_t)HALF * g.K1 * 2, hstep2 = (size_t)HALF * g.K2 * 2, hB1 = (size_t)32 * g.K1 * 2, hB2 = (size_t)32 * g.K2 * 2;
    const unsigned ldsw = (unsigned)wid * 1024u;
    const int aoff = lds_byte(wr * 64 + fr, fq * 8), boff = lds_byte(wc * 32 + fr, fq * 8);
#define PG8_SA(b, h) (((b) * 2 + (h)) * HTB)
#define PG8_SB(b, h) ((4 + (b) * 2 + (h)) * HTB)
#define PG8_STAGE(bufoff, gbase, voff) do { _Pragma("unroll") for (int _i = 0; _i < 2; ++_i) \
        __builtin_amdgcn_global_load_lds((const unsigned*)((const char*)(gbase) + (voff)[_i]), (PG8_LAS unsigned*)(lds + (bufoff) + ldsw + _i * 8192), 16, 0, 0); } while (0)
#define PG8_LDA(dst, b, h) do { _Pragma("unroll") for (int m = 0; m < 4; ++m) _Pragma("unroll") for (int k = 0; k < 2; ++k) dst[m][k] = *(const PG8_LAS bf16x8*)(lds + PG8_SA(b, h) + aoff + m * 2048 + k * 1024); } while (0)
#define PG8_LDB(dst, b, h) do { _Pragma("unroll") for (int n = 0; n < 2; ++n) _Pragma("unroll") for (int k = 0; k < 2; ++k) dst[n][k] = *(const PG8_LAS bf16x8*)(lds + PG8_SB(b, h) + boff + n * 2048 + k * 1024); } while (0)
#define PG8_MMA(ai, bj, At, Bt) do { __builtin_amdgcn_s_setprio(1); _Pragma("unroll") for (int m = 0; m < 4; ++m) _Pragma("unroll") for (int n = 0; n < 2; ++n) _Pragma("unroll") for (int k = 0; k < 2; ++k) \
        acc[ai][bj][m][n] = __builtin_amdgcn_mfma_f32_16x16x32_bf16(Bt[n][k], At[m][k], acc[ai][bj][m][n], 0, 0, 0); __builtin_amdgcn_s_setprio(0); } while (0)
#define PG8_WAIT_V(n) asm volatile("s_waitcnt vmcnt(" #n ")" ::: "memory")
#define PG8_WAIT_L(n) asm volatile("s_waitcnt lgkmcnt(" #n ")" ::: "memory")
#define PG8_BAR __builtin_amdgcn_s_barrier()
#define PG8_SCHED __builtin_amdgcn_sched_barrier(0)
    Unit cur, nxt; int ui = 0;
    if (!S.next(0, cur)) return;
    f32x4 acc[2][2][4][2];
#pragma unroll
    for (int a = 0; a < 2; ++a)
#pragma unroll
        for (int b = 0; b < 2; ++b)
#pragma unroll
            for (int m = 0; m < 4; ++m)
#pragma unroll
                for (int n = 0; n < 2; ++n) acc[a][b][m][n] = (f32x4){0.f, 0.f, 0.f, 0.f};
    bf16x8 At[4][2], B0[2][2], B1[2][2];
    const char* cA1 = (const char*)g.A1 + (size_t)cur.pm * 2 * hstep1; const char* cB1 = (const char*)g.B1t + (size_t)cur.pn * 2 * hstep1;
    const char* cA2 = (const char*)g.A2 + (size_t)cur.pm * 2 * hstep2; const char* cB2 = (const char*)g.B2t + (size_t)cur.pn * 2 * hstep2;
    {
    unsigned voffA1[2], voffB1[2];
#pragma unroll
    for (int i = 0; i < 2; ++i) { voffA1[i] = rA2[i] * (unsigned)g.K1 + c2[i]; voffB1[i] = rB2[i] * (unsigned)g.K1 + c2[i]; }
    PG8_STAGE(PG8_SB(0, 0), cB1, voffB1); PG8_STAGE(PG8_SB(0, 1), cB1 + hB1, voffB1); PG8_STAGE(PG8_SA(0, 0), cA1, voffA1); PG8_STAGE(PG8_SA(0, 1), cA1 + hstep1, voffA1);
    if (wr == 1) PG8_BAR;
    PG8_WAIT_V(2); PG8_BAR;
    PG8_STAGE(PG8_SB(1, 0), cB1 + kstep, voffB1); PG8_STAGE(PG8_SA(1, 0), cA1 + kstep, voffA1); PG8_STAGE(PG8_SB(1, 1), cB1 + hB1 + kstep, voffB1);
    PG8_WAIT_V(6); PG8_BAR;
    }
    for (;;) {
        const bool has_next = S.next(ui + 1, nxt);
        const char* nA1 = has_next ? (const char*)g.A1 + (size_t)nxt.pm * 2 * hstep1 : cA1; const char* nB1 = has_next ? (const char*)g.B1t + (size_t)nxt.pn * 2 * hstep1 : cB1;
        for (int t = 0; t < nt; t += 2) {
            const bool last = (t == nt - 2);
            const bool s1 = (t >= nt1);
            const bool s2 = !last && (t + 2 >= nt1);
            const char* a1 = s1 ? cA2 + (size_t)(t + 1 - nt1) * kstep : cA1 + (size_t)(t + 1) * kstep;
            const size_t h1 = s1 ? hstep2 : hstep1, h2 = s2 ? hstep2 : hstep1, hb2 = s2 ? hB2 : hB1;
            const char* a2 = last ? nA1 : (s2 ? cA2 + (size_t)(t + 2 - nt1) * kstep : cA1 + (size_t)(t + 2) * kstep);
            const char* b2 = last ? nB1 : (s2 ? cB2 + (size_t)(t + 2 - nt1) * kstep : cB1 + (size_t)(t + 2) * kstep);
            const char* a3 = a2 + kstep; const char* b3 = b2 + kstep;
            const unsigned k1 = (unsigned)(s1 ? g.K2 : g.K1), k2 = (unsigned)(s2 ? g.K2 : g.K1);
            unsigned vA1[2], vA2[2], vB2[2];
#pragma unroll
            for (int i = 0; i < 2; ++i) { vA1[i] = rA2[i] * k1 + c2[i]; vA2[i] = rA2[i] * k2 + c2[i]; vB2[i] = rB2[i] * k2 + c2[i]; }
            if (t == nt1) E.mid(acc, cur, wr, wc, fr, fq);
            PG8_LDB(B0, 0, 0); PG8_LDB(B1, 0, 1); PG8_SCHED; PG8_LDA(At, 0, 0); PG8_STAGE(PG8_SA(1, 1), a1 + h1, vA1);
            PG8_WAIT_V(8); PG8_WAIT_L(0); PG8_BAR; PG8_MMA(0, 0, At, B0); PG8_MMA(0, 1, At, B1); PG8_BAR; PG8_SCHED;
            PG8_LDA(At, 0, 1); PG8_STAGE(PG8_SB(0, 0), b2, vB2); PG8_STAGE(PG8_SB(0, 1), b2 + hb2, vB2); PG8_STAGE(PG8_SA(0, 0), a2, vA2);
            PG8_WAIT_V(8); PG8_WAIT_L(0); PG8_BAR; PG8_MMA(1, 0, At, B0); PG8_MMA(1, 1, At, B1); PG8_BAR; PG8_SCHED;
            PG8_LDB(B0, 1, 0); PG8_LDB(B1, 1, 1); PG8_SCHED; PG8_LDA(At, 1, 0); PG8_STAGE(PG8_SA(0, 1), a2 + h2, vA2);
            PG8_WAIT_V(8); PG8_WAIT_L(0); PG8_BAR; PG8_MMA(0, 0, At, B0); PG8_MMA(0, 1, At, B1); PG8_BAR; PG8_SCHED;
            PG8_LDA(At, 1, 1); PG8_STAGE(PG8_SB(1, 0), b3, vB2); PG8_STAGE(PG8_SB(1, 1), b3 + hb2, vB2); PG8_STAGE(PG8_SA(1, 0), a3, vA2);
            PG8_WAIT_V(8); PG8_WAIT_L(0); PG8_BAR; PG8_MMA(1, 0, At, B0); PG8_MMA(1, 1, At, B1); PG8_BAR; PG8_SCHED;
        }
        if (wr == 0) PG8_BAR;
        E(acc, cur, wr, wc, fr, fq);
        if (!has_next) break;
#pragma unroll
        for (int a = 0; a < 2; ++a)
#pragma unroll
            for (int b = 0; b < 2; ++b)
#pragma unroll
                for (int m = 0; m < 4; ++m)
#pragma unroll
                    for (int n = 0; n < 2; ++n) acc[a][b][m][n] = (f32x4){0.f, 0.f, 0.f, 0.f};
        cur = nxt; cA1 = nA1; cB1 = nB1;
        cA2 = (const char*)g.A2 + (size_t)cur.pm * 2 * hstep2; cB2 = (const char*)g.B2t + (size_t)cur.pn * 2 * hstep2; ++ui;
        if (wr == 1) PG8_BAR;
    }
    PG8_WAIT_V(0);
    PG8_BAR;
#undef PG8_SA
#undef PG8_SB
#undef PG8_STAGE
#undef PG8_LDA
#undef PG8_LDB
#undef PG8_MMA
#undef PG8_WAIT_V
#undef PG8_WAIT_L
#undef PG8_BAR
#undef PG8_SCHED
}
}

#define LAS __attribute__((address_space(3)))
typedef unsigned short bf16;
typedef pg8::f32x4 f32x4;
typedef pg8::u32x4 u32x4;
typedef pg8::bf16x8 bf16x8;
typedef unsigned u32x2 __attribute__((ext_vector_type(2)));
typedef float f32x2v __attribute__((ext_vector_type(2)));

constexpr int NB = 4, SEQ = 8192, D = 1024, M = NB * SEQ;
constexpr int NH = 4, DK = 256, DV = 512;
constexpr int NT1 = 24, NT2 = 20, NIN = (NT1 + NT2) * 256;
constexpr int NPHASE = 10;

constexpr size_t MiB = 1u << 20;
constexpr size_t WS_CTL = 0, CTL_BYTES = 1 * MiB;
constexpr size_t WS_MOD = 1 * MiB;
constexpr size_t WS_WIN = 2 * MiB;
constexpr size_t WS_WRET = 24 * MiB;
constexpr size_t WS_WCONV = 28 * MiB;
constexpr size_t WS_WOUT = 30 * MiB;
constexpr size_t WS_H = 32 * MiB;
constexpr size_t WS_Q = 96 * MiB;
constexpr size_t WS_K = 160 * MiB;
constexpr size_t WS_V = 224 * MiB;
constexpr size_t WS_ZR = 352 * MiB;
constexpr size_t WS_END = 480 * MiB;
constexpr int CW_BAR = 4096;

typedef float f32x2_t __attribute__((ext_vector_type(2)));
typedef __bf16 bf16x2_t __attribute__((ext_vector_type(2)));
__device__ __forceinline__ unsigned cvt_pk(float lo, float hi) { const f32x2_t v = {lo, hi}; const bf16x2_t b = __builtin_convertvector(v, bf16x2_t); return __builtin_bit_cast(unsigned, b); }
__device__ __forceinline__ float bf_lo(unsigned u) { return __uint_as_float(u << 16); }
__device__ __forceinline__ float bf_hi(unsigned u) { return __uint_as_float(u & 0xffff0000u); }
__device__ __forceinline__ float fsigmoid(float x) { return __builtin_amdgcn_rcpf(1.0f + __builtin_amdgcn_exp2f(x * -1.4426950408889634f)); }
__device__ __forceinline__ float fsilu(float x) { return x * fsigmoid(x); }

typedef unsigned v4u_t __attribute__((__vector_size__(4 * sizeof(unsigned))));
#define EB_RSRC(p) __builtin_amdgcn_make_buffer_rsrc((void*)(p), (short)0, 0x7fffffff, 0x00020000)
__device__ __forceinline__ unsigned dpp_ror8(unsigned v) { return (unsigned)__builtin_amdgcn_update_dpp(0, (int)v, 0x128, 0xF, 0xF, true); }
__device__ __forceinline__ void store_lines(bf16* own, int ld, int fr, const u32x4& p0, const u32x4& p1) {
    const bool lo = fr < 8;
    u32x4 x, r;
    x.x = lo ? p1.x : p0.x; x.y = lo ? p1.y : p0.y; x.z = lo ? p1.z : p0.z; x.w = lo ? p1.w : p0.w;
    r.x = dpp_ror8(x.x); r.y = dpp_ror8(x.y); r.z = dpp_ror8(x.z); r.w = dpp_ror8(x.w);
    u32x4 a, b;
    a.x = lo ? p0.x : r.x; a.y = lo ? p0.y : r.y; a.z = lo ? p0.z : r.z; a.w = lo ? p0.w : r.w;
    b.x = lo ? r.x : p1.x; b.y = lo ? r.y : p1.y; b.z = lo ? r.z : p1.z; b.w = lo ? r.w : p1.w;
    bf16* pa = lo ? own : own - (size_t)8 * ld + 32;
    bf16* pb = lo ? own + (size_t)8 * ld : own + 32;
    *(u32x4*)pa = a; *(u32x4*)pb = b;
}
__device__ __forceinline__ u32x4 pack8(const f32x4& v0, const f32x4& v1) { u32x4 w; w.x = cvt_pk(v0[0], v0[1]); w.y = cvt_pk(v0[2], v0[3]); w.z = cvt_pk(v1[0], v1[1]); w.w = cvt_pk(v1[2], v1[3]); return w; }

struct EpiProj1 {
    static constexpr bool PERM = true, AFTER_DRAIN = false;
    bf16* Q; bf16* K; bf16* V; bf16* ZR; const int* pos;
    __device__ __forceinline__ void operator()(const f32x4 (&acc)[2][2][4][2], const pg8::Unit& u, int wr, int wc, int fr, int fq) const {
        const int row0 = u.pm * 256 + wr * 64 + fr, cl = wc * 64 + 8 * fq, pn = u.pn;
        if (pn < 8) {
            bf16* base = (pn < 4 ? Q : K) + (pn & 3) * 256 + cl;
            const float sc = pn < 4 ? 1.0f : 0.0625f;
            float invf[8];
#pragma unroll
            for (int i = 0; i < 8; ++i) invf[i] = exp2f((float)(wc * 32 + 8 * fq + i) * (-13.287712379549449f / 128.0f));
            int pr[8];
#pragma unroll
            for (int i = 0; i < 8; ++i) pr[i] = pos[row0 + (i >> 2) * 128 + (i & 3) * 16];
#pragma unroll
            for (int ai = 0; ai < 2; ++ai)
#pragma unroll
                for (int m = 0; m < 4; ++m) {
                    const float p = (float)pr[ai * 4 + m];
                    float o1[8], o2[8];
#pragma unroll
                    for (int n = 0; n < 2; ++n)
#pragma unroll
                        for (int j = 0; j < 4; ++j) {
                            const float ang = p * invf[n * 4 + j];
                            const float nn = rintf(ang * 0.15915494309189535f);
                            float r = fmaf(-nn, 6.2831854820251465f, ang);
                            r = fmaf(-nn, -1.7484555e-7f, r);
                            const float rv = r * 0.15915494309189535f;
                            const float s = __builtin_amdgcn_sinf(rv), c = __builtin_amdgcn_cosf(rv);
                            const float t1 = acc[ai][0][m][n][j], t2 = acc[ai][1][m][n][j];
                            o1[n * 4 + j] = (t1 * c - t2 * s) * sc; o2[n * 4 + j] = (t1 * s + t2 * c) * sc;
                        }
                    u32x4 w1, w2;
                    w1.x = cvt_pk(o1[0], o1[1]); w1.y = cvt_pk(o1[2], o1[3]); w1.z = cvt_pk(o1[4], o1[5]); w1.w = cvt_pk(o1[6], o1[7]);
                    w2.x = cvt_pk(o2[0], o2[1]); w2.y = cvt_pk(o2[2], o2[3]); w2.z = cvt_pk(o2[4], o2[5]); w2.w = cvt_pk(o2[6], o2[7]);
                    store_lines(base + (size_t)(row0 + ai * 128 + m * 16) * 1024, 1024, fr, w1, w2);
                }
        } else {
            bf16* base = (pn >= 16 ? ZR + (pn - 16) * 256 : V + (pn - 8) * 256) + cl;
#pragma unroll
            for (int ai = 0; ai < 2; ++ai)
#pragma unroll
                for (int m = 0; m < 4; ++m)
                    store_lines(base + (size_t)(row0 + ai * 128 + m * 16) * 2048, 2048, fr, pack8(acc[ai][0][m][0], acc[ai][0][m][1]), pack8(acc[ai][1][m][0], acc[ai][1][m][1]));
        }
    }
};
struct EpiNull {
    static constexpr bool PERM = true, AFTER_DRAIN = false;
    __device__ __forceinline__ void operator()(const f32x4 (&acc)[2][2][4][2], const pg8::Unit&, int, int, int, int) const {
#pragma unroll
        for (int a = 0; a < 2; ++a)
#pragma unroll
            for (int b = 0; b < 2; ++b)
#pragma unroll
                for (int m = 0; m < 4; ++m) asm volatile("" :: "v"(acc[a][b][m][0]), "v"(acc[a][b][m][1]));
    }
};
struct EpiProj2 {
    static constexpr bool PERM = true, AFTER_DRAIN = false;
    bf16* A; bf16* ZC; bf16* SGA; bf16* SGB;
    __device__ __forceinline__ void operator()(const f32x4 (&acc)[2][2][4][2], const pg8::Unit& u, int wr, int wc, int fr, int fq) const {
        const int row0 = u.pm * 256 + wr * 64 + fr, pn = u.pn;
        if (pn < 8) {
            bf16* base = A + pn * 128 + wc * 32 + 8 * fq;
#pragma unroll
            for (int ai = 0; ai < 2; ++ai)
#pragma unroll
                for (int m = 0; m < 4; ++m) {
                    f32x4 v0 = acc[ai][0][m][0], v1 = acc[ai][0][m][1]; const f32x4 g0 = acc[ai][1][m][0], g1 = acc[ai][1][m][1];
#pragma unroll
                    for (int j = 0; j < 4; ++j) { v0[j] *= fsigmoid(g0[j]); v1[j] *= fsigmoid(g1[j]); }
                    *(u32x4*)(base + (size_t)(row0 + ai * 128 + m * 16) * 1024) = pack8(v0, v1);
                }
        } else {
            const bool isz = pn < 12;
            bf16* base = (isz ? ZC + (pn - 8) * 256 : (pn < 16 ? SGA + (pn - 12) * 256 : SGB + (pn - 16) * 256)) + wc * 64 + 8 * fq;
#pragma unroll
            for (int ai = 0; ai < 2; ++ai)
#pragma unroll
                for (int m = 0; m < 4; ++m) {
                    f32x4 v[2][2];
#pragma unroll
                    for (int bj = 0; bj < 2; ++bj)
#pragma unroll
                        for (int n = 0; n < 2; ++n) { v[bj][n] = acc[ai][bj][m][n];
                            if (!isz) {
#pragma unroll
                                for (int j = 0; j < 4; ++j) v[bj][n][j] = fsigmoid(v[bj][n][j]); } }
                    store_lines(base + (size_t)(row0 + ai * 128 + m * 16) * 1024, 1024, fr, pack8(v[0][0], v[0][1]), pack8(v[1][0], v[1][1]));
                }
        }
    }
};
struct EpiMerge {
    static constexpr bool PERM = true, AFTER_DRAIN = false;
    const bf16* SGA; const bf16* SGB; bf16* MG;
    __device__ __forceinline__ void mid(f32x4 (&acc)[2][2][4][2], const pg8::Unit& u, int wr, int wc, int fr, int fq) const {
        const __amdgpu_buffer_rsrc_t ra = EB_RSRC(SGA), rb = EB_RSRC(SGB);
        const unsigned vo = (unsigned)(((u.pm * 256 + wr * 64 + fr) * 1024 + u.pn * 256 + wc * 64 + 8 * fq) * 2);
#pragma unroll
        for (int ai = 0; ai < 2; ++ai)
#pragma unroll
            for (int m = 0; m < 4; ++m)
#pragma unroll
                for (int bj = 0; bj < 2; ++bj) {
                    const int so = ((ai * 128 + m * 16) * 1024 + bj * 32) * 2;
                    const u32x4 a = __builtin_bit_cast(u32x4, __builtin_amdgcn_raw_buffer_load_b128(ra, vo, so, 0)), b = __builtin_bit_cast(u32x4, __builtin_amdgcn_raw_buffer_load_b128(rb, vo, so, 0));
                    f32x4& v0 = acc[ai][bj][m][0]; f32x4& v1 = acc[ai][bj][m][1];
                    v0[0] *= bf_lo(a.x) * __builtin_amdgcn_rcpf(bf_lo(b.x)); v0[1] *= bf_hi(a.x) * __builtin_amdgcn_rcpf(bf_hi(b.x)); v0[2] *= bf_lo(a.y) * __builtin_amdgcn_rcpf(bf_lo(b.y)); v0[3] *= bf_hi(a.y) * __builtin_amdgcn_rcpf(bf_hi(b.y));
                    v1[0] *= bf_lo(a.z) * __builtin_amdgcn_rcpf(bf_lo(b.z)); v1[1] *= bf_hi(a.z) * __builtin_amdgcn_rcpf(bf_hi(b.z)); v1[2] *= bf_lo(a.w) * __builtin_amdgcn_rcpf(bf_lo(b.w)); v1[3] *= bf_hi(a.w) * __builtin_amdgcn_rcpf(bf_hi(b.w));
                }
    }
    __device__ __forceinline__ void operator()(const f32x4 (&acc)[2][2][4][2], const pg8::Unit& u, int wr, int wc, int fr, int fq) const {
        const __amdgpu_buffer_rsrc_t rb = EB_RSRC(SGB);
        const int row0 = u.pm * 256 + wr * 64 + fr;
        const unsigned vo = (unsigned)((row0 * 1024 + u.pn * 256 + wc * 64 + 8 * fq) * 2);
        u32x4 g[16];
#pragma unroll
        for (int i = 0; i < 16; ++i) g[i] = __builtin_bit_cast(u32x4, __builtin_amdgcn_raw_buffer_load_b128(rb, vo, (((i >> 3) * 128 + ((i >> 1) & 3) * 16) * 1024 + (i & 1) * 32) * 2, 0));
        bf16* base = MG + u.pn * 256 + wc * 64 + 8 * fq;
#pragma unroll
        for (int ai = 0; ai < 2; ++ai)
#pragma unroll
            for (int m = 0; m < 4; ++m) {
                u32x4 w[2];
#pragma unroll
                for (int bj = 0; bj < 2; ++bj) { const u32x4 gg = g[ai * 8 + m * 2 + bj]; const f32x4 v0 = acc[ai][bj][m][0], v1 = acc[ai][bj][m][1];
                    w[bj].x = cvt_pk(v0[0] * bf_lo(gg.x), v0[1] * bf_hi(gg.x)); w[bj].y = cvt_pk(v0[2] * bf_lo(gg.y), v0[3] * bf_hi(gg.y)); w[bj].z = cvt_pk(v1[0] * bf_lo(gg.z), v1[1] * bf_hi(gg.z)); w[bj].w = cvt_pk(v1[2] * bf_lo(gg.w), v1[3] * bf_hi(gg.w)); }
                store_lines(base + (size_t)(row0 + ai * 128 + m * 16) * 1024, 1024, fr, w[0], w[1]);
            }
    }
};
struct EpiY {
    static constexpr bool PERM = true, AFTER_DRAIN = false;
    bf16* Y;
    __device__ __forceinline__ void operator()(const f32x4 (&acc)[2][2][4][2], const pg8::Unit& u, int wr, int wc, int fr, int fq) const {
        const int row0 = u.pm * 256 + wr * 64 + fr;
        bf16* base = Y + u.pn * 256 + wc * 64 + 8 * fq;
#pragma unroll
        for (int ai = 0; ai < 2; ++ai)
#pragma unroll
            for (int m = 0; m < 4; ++m)
                store_lines(base + (size_t)(row0 + ai * 128 + m * 16) * 1024, 1024, fr, pack8(acc[ai][0][m][0], acc[ai][0][m][1]), pack8(acc[ai][1][m][0], acc[ai][1][m][1]));
    }
};
#define XB_TMO      128
#define XB_XCNT(j)  (256  + 64 * (j))
#define XB_XSUB(j)  (1280 + 64 * (j))
#define XB_XGEN(j)  (2304 + 64 * (j))
#define XB_TOP      3328
#define XB_TOPGEN   3392
#define XCD_BAR_WORDS 3456
#define XB_SPIN_CAP (1u << 21)

__device__ __forceinline__ unsigned xb_ld(unsigned* p)              { return __hip_atomic_load(p, __ATOMIC_RELAXED, __HIP_MEMORY_SCOPE_AGENT); }
__device__ __forceinline__ unsigned xb_add(unsigned* p, unsigned v) { return __hip_atomic_fetch_add(p, v, __ATOMIC_RELAXED, __HIP_MEMORY_SCOPE_AGENT); }
__device__ __forceinline__ unsigned xb_xcc_id() { return (unsigned)__builtin_amdgcn_s_getreg((3 << 11) | 20) & 0xFu; }
#define XB_SPIN(cond, bar) do { unsigned _sp = 0; while (cond) { __builtin_amdgcn_s_sleep(1); \
    if ((++_sp & 255u) == 0u) { if (xb_ld(&(bar)[XB_TMO])) break; if (_sp > XB_SPIN_CAP) { atomicAdd(&(bar)[XB_TMO], 1u); break; } } } } while (0)

struct XcdBarrier {
    unsigned* bar; unsigned x;
    volatile LAS unsigned* st;
};

__device__ __forceinline__ XcdBarrier xcd_barrier_post(unsigned* bar, volatile LAS unsigned* st) {
    XcdBarrier b; b.bar = bar; b.x = xb_xcc_id(); b.st = st;
    if (threadIdx.x == 0) (void)xb_add(&bar[XB_XCNT(b.x)], 1u);
    return b;
}
__device__ __forceinline__ void xcd_barrier_complete(unsigned* bar, unsigned x, unsigned& nloc, unsigned& nx) {
    const unsigned G = gridDim.x * gridDim.y * gridDim.z;
    unsigned sum, cnt, mine, sp = 0u;
    for (;;) {
        sum = 0u; cnt = 0u; mine = 0u;
#pragma unroll
        for (unsigned j = 0; j < 16; ++j) { const unsigned c = xb_ld(&bar[XB_XCNT(j)]); sum += c; cnt += (c > 0u) ? 1u : 0u; mine = (j == x) ? c : mine; }
        if (sum == G) break;
        __builtin_amdgcn_s_sleep(1);
        if ((++sp & 255u) == 0u) { if (xb_ld(&bar[XB_TMO])) break; if (sp > XB_SPIN_CAP) { atomicAdd(&bar[XB_TMO], 1u); break; } }
    }
    nloc = mine > 0u ? mine : 1u; nx = cnt > 0u ? cnt : 1u;
}

__device__ __forceinline__ void xcd_barrier(const XcdBarrier& b) {
    asm volatile("s_waitcnt vmcnt(0)" ::: "memory");
    __syncthreads();
    if (threadIdx.x == 0) {
        unsigned* bar = b.bar;
        __builtin_amdgcn_s_waitcnt(0);
        unsigned nloc = b.st[0], nx = b.st[1];
        if (nloc == 0u) { xcd_barrier_complete(bar, b.x, nloc, nx); b.st[0] = nloc; b.st[1] = nx; }
        const unsigned old = xb_add(&bar[XB_XSUB(b.x)], 1u);
        const unsigned gen = old / nloc;
        if (old + 1u == (gen + 1u) * nloc) {
            __builtin_amdgcn_fence(__ATOMIC_RELEASE, "agent");
            asm volatile("s_waitcnt vmcnt(0)" ::: "memory");
            const unsigned og = xb_add(&bar[XB_TOP], 1u);
            const unsigned tg = og / nx;
            if (og + 1u == (tg + 1u) * nx) xb_add(&bar[XB_TOPGEN], 1u);
            else XB_SPIN(xb_ld(&bar[XB_TOPGEN]) == tg, bar);
            __builtin_amdgcn_fence(__ATOMIC_ACQUIRE, "agent");
            xb_add(&bar[XB_XGEN(b.x)], 1u);
            asm volatile("s_waitcnt vmcnt(0)" ::: "memory");
        } else {
            XB_SPIN(xb_ld(&bar[XB_XGEN(b.x)]) == gen, bar);
            __builtin_amdgcn_fence(__ATOMIC_ACQUIRE, "agent");
            asm volatile("s_waitcnt vmcnt(0)" ::: "memory");
        }
    }
    __syncthreads();
}

constexpr int RING_BYTES = 153600;
constexpr int LDSCTL_OFF = RING_BYTES, MISC_OFF = LDSCTL_OFF + 320;
constexpr int LDS_BYTES = 161792;
struct Frame {
    LAS unsigned char* lds;
    volatile LAS unsigned* MISC;
    unsigned* ctl;
    int tid, lane, wave, vcu, G;
    const float *x, *c, *w_ada, *b_ada, *pre_g, *w_in, *conv_w, *conv_b, *ln_g, *ln_b, *w_ret, *w_conv, *w_out, *post_g;
    const int* pos;
    float* out; float* mod;
    bf16 *WIN, *WRET, *WCONV, *WOUT, *H, *Q, *K, *V, *ZR, *SGA, *SGB;
    float* F32S;
    bf16* YB;
};
#define DPP_ADD(v, ctrl, row_mask) ((v) + __int_as_float(__builtin_amdgcn_update_dpp(0, __float_as_int(v), ctrl, row_mask, 0xF, true)))
__device__ __forceinline__ float wave_sum(float v) {
    v = DPP_ADD(v, 0xB1, 0xF);
    v = DPP_ADD(v, 0x4E, 0xF);
    v = DPP_ADD(v, 0x141, 0xF);
    v = DPP_ADD(v, 0x140, 0xF);
    v = DPP_ADD(v, 0x142, 0xA);
    v = DPP_ADD(v, 0x143, 0xC);
    return __int_as_float(__builtin_amdgcn_readlane(__float_as_int(v), 63));
}
#define LDS_WAIT() asm volatile("s_waitcnt lgkmcnt(0)" ::: "memory")
#define RAW_BAR() do { asm volatile("s_waitcnt lgkmcnt(0)" ::: "memory"); __builtin_amdgcn_s_barrier(); asm volatile("" ::: "memory"); } while (0)

__device__ __forceinline__ void transpose_item(const float* W, int K, int N, bf16* WT, int dst_row0, int src_col0, int k0, LAS float* scr, int lane) {
#pragma unroll 8
    for (int i = 0; i < 32; ++i) { const int kk = 2 * i + (lane >> 5); scr[kk * 33 + (lane & 31)] = W[(size_t)(k0 + kk) * N + src_col0 + (lane & 31)]; }
    LDS_WAIT(); asm volatile("" ::: "memory");
    const int c = lane & 7;
#pragma unroll
    for (int j = 0; j < 4; ++j) { const int n = (lane >> 3) + 8 * j; const LAS float* s = scr + (8 * c) * 33 + n;
        u32x4 o; o.x = cvt_pk(s[0 * 33], s[1 * 33]); o.y = cvt_pk(s[2 * 33], s[3 * 33]); o.z = cvt_pk(s[4 * 33], s[5 * 33]); o.w = cvt_pk(s[6 * 33], s[7 * 33]);
        *(u32x4*)(WT + (size_t)(dst_row0 + n) * K + k0 + 8 * c) = o; }
    LDS_WAIT(); asm volatile("" ::: "memory");
}
__device__ __forceinline__ int win_src_col(int n0) {
    const int tile = n0 >> 8, wcb = (n0 >> 6) & 3, bj = (n0 >> 5) & 1;
    if (tile < 8) return tile * 256 + 128 * bj + 32 * wcb;
    if (tile >= 24 && tile < 32) return (bj ? 7168 : 6144) + 128 * (tile - 24) + 32 * wcb;
    return n0;
}
__device__ __forceinline__ void phase0(Frame& F) {
    LAS float* red = (LAS float*)F.lds;
    for (int cg = blockIdx.x; cg < 48; cg += F.G) {
        const int col = cg * 64 + F.lane; float a0 = 0.f, a1 = 0.f, a2 = 0.f, a3 = 0.f;
        const int kb = F.wave * 128;
#pragma unroll 16
        for (int k = 0; k < 128; ++k) { const float wv = F.w_ada[(size_t)(kb + k) * 3072 + col];
            a0 = fmaf(F.c[kb + k], wv, a0); a1 = fmaf(F.c[1024 + kb + k], wv, a1); a2 = fmaf(F.c[2048 + kb + k], wv, a2); a3 = fmaf(F.c[3072 + kb + k], wv, a3); }
        red[(F.wave * 4 + 0) * 64 + F.lane] = a0; red[(F.wave * 4 + 1) * 64 + F.lane] = a1; red[(F.wave * 4 + 2) * 64 + F.lane] = a2; red[(F.wave * 4 + 3) * 64 + F.lane] = a3;
        __syncthreads();
        if (F.wave < 4) { float s = 0.f;
#pragma unroll
            for (int w = 0; w < 8; ++w) s += red[(w * 4 + F.wave) * 64 + F.lane];
            F.mod[F.wave * 3072 + col] = s + F.b_ada[col]; }
        __syncthreads();
    }
    LAS float* scr = (LAS float*)(F.lds + F.wave * 8448);
    const int gw = F.vcu * 8 + F.wave, NGW = F.G * 8;
    constexpr int I_IN = 16 * 352, I_RET = 32 * 32, I_CV = 16 * 32, I_OUT = 16 * 32;
    for (int it = gw; it < I_IN + I_RET + I_CV + I_OUT; it += NGW) {
        int r = it;
        if (r < I_IN) { const int kb = r / 352, nb = r % 352; transpose_item(F.w_in, 1024, NIN, F.WIN, nb * 32, win_src_col(nb * 32), kb * 64, scr, F.lane); continue; } r -= I_IN;
        if (r < I_RET) { const int kb = r >> 5, nb = r & 31; transpose_item(F.w_ret, 2048, 1024, F.WRET, nb * 32, nb * 32, kb * 64, scr, F.lane); continue; } r -= I_RET;
        if (r < I_CV) { const int kb = r >> 5, nb = r & 31; transpose_item(F.w_conv, 1024, 1024, F.WCONV, nb * 32, nb * 32, kb * 64, scr, F.lane); continue; } r -= I_CV;
        { const int kb = r >> 5, nb = r & 31; transpose_item(F.w_out, 1024, 1024, F.WOUT, nb * 32, nb * 32, kb * 64, scr, F.lane); }
    }
}
__device__ __forceinline__ void phase1(Frame& F) {
    const int gw = F.vcu * 8 + F.wave, NGW = F.G * 8;
    for (int rb = gw; rb < M / 16; rb += NGW) {
        const int b = (rb * 16) / SEQ;
        f32x4 ca[4], cs[4];
#pragma unroll
        for (int j = 0; j < 4; ++j) { const int col = 4 * F.lane + 256 * j;
            const f32x4 g = *(const f32x4*)(F.pre_g + col), sc = *(const f32x4*)(F.mod + b * 3072 + 1024 + col);
            ca[j] = g * (sc + 1.0f); cs[j] = *(const f32x4*)(F.mod + b * 3072 + col); }
        for (int r = 0; r < 16; r += 4) {
            const size_t m = (size_t)rb * 16 + r;
            f32x4 v[4][4]; float ss[4];
#pragma unroll
            for (int q = 0; q < 4; ++q) { const f32x4* xr = (const f32x4*)(F.x + (m + q) * D) + F.lane;
#pragma unroll
                for (int j = 0; j < 4; ++j) v[q][j] = xr[64 * j]; }
#pragma unroll
            for (int q = 0; q < 4; ++q) { float s = 0.f;
#pragma unroll
                for (int j = 0; j < 4; ++j) s += (v[q][j][0] * v[q][j][0] + v[q][j][1] * v[q][j][1]) + (v[q][j][2] * v[q][j][2] + v[q][j][3] * v[q][j][3]);
                ss[q] = s; }
#pragma unroll
            for (int q = 0; q < 4; ++q) ss[q] = wave_sum(ss[q]);
#pragma unroll
            for (int q = 0; q < 4; ++q) { const float rstd = rsqrtf(ss[q] * (1.0f / D) + 1e-6f);
                u32x2* o8 = (u32x2*)(F.H + (m + q) * D) + F.lane;
#pragma unroll
                for (int j = 0; j < 4; ++j) { const f32x4 y = v[q][j] * rstd * ca[j] + cs[j]; u32x2 w; w.x = cvt_pk(y[0], y[1]); w.y = cvt_pk(y[2], y[3]); o8[64 * j] = w; } }
        }
    }
}
constexpr int R_ROW = 528, R_PROW = 160, R_VROW = 272;
constexpr int R_QS = 0, R_KS = 64 * R_ROW, R_P = 2 * 64 * R_ROW, R_VZ = R_P + 64 * R_PROW, R_END = R_VZ + 64 * R_VROW;
static_assert(R_END <= RING_BYTES, "retention LDS map");
typedef short v4i16_t __attribute__((ext_vector_type(4)));
__device__ __forceinline__ bf16x8 ldfrag(const LAS unsigned char* p) { return *(const LAS bf16x8*)p; }
__device__ __forceinline__ v4i16_t ldtr(const LAS unsigned char* p) { return __builtin_amdgcn_ds_read_tr16_b64_v4i16((LAS v4i16_t*)p); }
__device__ __forceinline__ bf16x8 ldtr2(const LAS unsigned char* p, int step) {
    const v4i16_t t0 = ldtr(p), t1 = ldtr(p + step);
    bf16x8 f; f[0] = t0[0]; f[1] = t0[1]; f[2] = t0[2]; f[3] = t0[3]; f[4] = t1[0]; f[5] = t1[1]; f[6] = t1[2]; f[7] = t1[3]; return f;
}
__device__ __forceinline__ bf16x8 ld2x64(const LAS unsigned char* p0, const LAS unsigned char* p1) {
    const u32x2 a = *(const volatile LAS u32x2*)p0, b = *(const volatile LAS u32x2*)p1;
    u32x4 r; r.x = a.x; r.y = a.y; r.z = b.x; r.w = b.y; return __builtin_bit_cast(bf16x8, r);
}
__device__ __forceinline__ bf16x8 state_frag(const f32x4& s0, const f32x4& s1) {
    u32x4 r; r.x = cvt_pk(s0[0], s0[1]); r.y = cvt_pk(s0[2], s0[3]); r.z = cvt_pk(s1[0], s1[1]); r.w = cvt_pk(s1[2], s1[3]); return __builtin_bit_cast(bf16x8, r);
}
#define MFMA16(a, b, c) __builtin_amdgcn_mfma_f32_16x16x32_bf16(a, b, c, 0, 0, 0)
#define SCHED_FENCE() __builtin_amdgcn_sched_barrier(0)
#define RET_QS(AF_EXPR)                                                                                                      \
    {                                                                                                                         \
        bf16x8 qb[2][4];                                                                                                      \
        _Pragma("unroll") for (int ib = 0; ib < 4; ++ib) { const LAS unsigned char* qp = lds + R_QS + (ib * 16 + fr) * R_ROW + (4 * fq) * 2; qb[0][ib] = ld2x64(qp, qp + 32); } \
        _Pragma("unroll") for (int kq = 0; kq < 8; ++kq) {                                                                    \
            if (kq < 7) { _Pragma("unroll") for (int ib = 0; ib < 4; ++ib) { const LAS unsigned char* qp = lds + R_QS + (ib * 16 + fr) * R_ROW + (32 * (kq + 1) + 4 * fq) * 2; qb[(kq + 1) & 1][ib] = ld2x64(qp, qp + 32); } } \
            const bf16x8 af = (AF_EXPR);                                                                                      \
            SCHED_FENCE();                                                                                                    \
            _Pragma("unroll") for (int ib = 0; ib < 4; ++ib) aQ[ib] = MFMA16(af, qb[kq & 1][ib], aQ[ib]);                     \
            SCHED_FENCE();                                                                                                    \
        }                                                                                                                     \
    }
#define RSRC(p) __builtin_amdgcn_make_buffer_rsrc((void*)(p), (short)0, 0x7fffffff, 0x00020000)
#define BLD128(r, vo, so) __builtin_bit_cast(u32x4, __builtin_amdgcn_raw_buffer_load_b128(r, vo, so, 0))
#define BLD64(r, vo, so) __builtin_bit_cast(u32x2, __builtin_amdgcn_raw_buffer_load_b64(r, vo, so, 0))
#define BST64(v, r, vo, so) __builtin_amdgcn_raw_buffer_store_b64(__builtin_bit_cast(v2u_t, v), r, vo, so, 0)
typedef unsigned v2u_t __attribute__((__vector_size__(2 * sizeof(unsigned))));
constexpr int C3_QS = 0, C3_KS = 32 * R_ROW, C3_VZ = 2 * 32 * R_ROW, C3_P = C3_VZ + 32 * R_VROW, C3_PROW = 80, C3_SET = C3_P + 32 * C3_PROW;
constexpr int C3_OST = 3 * C3_SET, C3_OROW = 272;
static_assert(C3_OST + 2 * 32 * C3_OROW <= RING_BYTES, "retention LDS map (3 sets + output staging)");
template <int ABL> __device__ __forceinline__ void ret_pass1(Frame& F) {
    LAS unsigned char* lds = F.lds;
    const int tid = F.tid, lane = F.lane, w = F.wave, fr = lane & 15, fq = lane >> 4;
    const int srow = tid >> 5, sc16 = tid & 31, vrow = tid >> 4, vc = tid & 15;
    const int sib = w >> 1, sjb = w & 1, sil = sib * 16 + fr, q4 = fr >> 2, p4 = fr & 3;
    float* Lw = (float*)F.out;
    for (int item = F.vcu; item < 256; item += F.G) {
        const int slice = item & 3, seg = (item >> 2) & 3, bh = item >> 4, b = bh >> 2, h = bh & 3;
        const float l2g = log2f(1.0f - exp2f(-5.0f - (float)h));
        const size_t tok0 = (size_t)b * SEQ + seg * 2048;
        const __amdgpu_buffer_rsrc_t Qg = RSRC(F.Q + tok0 * 1024 + h * 256), Kg = RSRC(F.K + tok0 * 1024 + h * 256), Vg = RSRC(F.V + tok0 * 2048 + h * 512 + slice * 128);
        unsigned oq[2], oo2[2];
#pragma unroll
        for (int i = 0; i < 2; ++i) { oq[i] = (unsigned)((srow + 16 * i) * 2048 + sc16 * 16); oo2[i] = (unsigned)((i * 16 + fr) * 4096 + (16 * w + 4 * fq) * 2); }
        const unsigned ov = (unsigned)(vrow * 4096 + vc * 16);
        const float zeta = exp2f((float)(31 - vrow) * l2g), gC = exp2f(32.0f * l2g);
        float rs1[2], xi[2];
#pragma unroll
        for (int ib = 0; ib < 2; ++ib) { rs1[ib] = exp2f((float)(ib * 16 + fr - 31) * l2g); xi[ib] = exp2f((float)(ib * 16 + fr + 1) * l2g); }
        f32x4 S[16];
#pragma unroll
        for (int i = 0; i < 16; ++i) S[i] = (f32x4){0.f, 0.f, 0.f, 0.f};
        u32x4 pq[2][2], pk[2][2], pv[2];
        const unsigned ostw = (unsigned)(fr * C3_OROW + 32 * w + 8 * fq), ostr = (unsigned)((tid >> 4) * C3_OROW + (tid & 15) * 16), ostg = (unsigned)((tid >> 4) * 4096 + (tid & 15) * 16);
#define P1_LOAD(r_, n_) do { _Pragma("unroll") for (int i_ = 0; i_ < 2; ++i_) { pq[r_][i_] = BLD128(Qg, oq[i_], (n_) * (32 * 2048)); pk[r_][i_] = BLD128(Kg, oq[i_], (n_) * (32 * 2048)); } pv[r_] = BLD128(Vg, ov, (n_) * (32 * 4096)); } while (0)
#define P1_WRITE(r_, set_) do { LAS unsigned char* sb_ = lds + (set_) * C3_SET; \
            _Pragma("unroll") for (int i_ = 0; i_ < 2; ++i_) { *(LAS u32x4*)(sb_ + C3_QS + (srow + 16 * i_) * R_ROW + sc16 * 16) = pq[r_][i_]; *(LAS u32x4*)(sb_ + C3_KS + (srow + 16 * i_) * R_ROW + sc16 * 16) = pk[r_][i_]; } \
            u32x4 o_; o_.x = cvt_pk(bf_lo(pv[r_].x) * zeta, bf_hi(pv[r_].x) * zeta); o_.y = cvt_pk(bf_lo(pv[r_].y) * zeta, bf_hi(pv[r_].y) * zeta); o_.z = cvt_pk(bf_lo(pv[r_].z) * zeta, bf_hi(pv[r_].z) * zeta); o_.w = cvt_pk(bf_lo(pv[r_].w) * zeta, bf_hi(pv[r_].w) * zeta); \
            *(LAS u32x4*)(sb_ + C3_VZ + vrow * R_VROW + vc * 16) = o_; } while (0)
#define P1_SCORES(set_) do { if (w < 4) { LAS unsigned char* sb_ = lds + (set_) * C3_SET; f32x4 s_ = (f32x4){0.f, 0.f, 0.f, 0.f}; \
            if (sjb <= sib) { const LAS unsigned char* qrow_ = sb_ + C3_QS + sil * R_ROW + fq * 16; const LAS unsigned char* krow_ = sb_ + C3_KS + (sjb * 16 + fr) * R_ROW + fq * 16; \
                bf16x8 sq_[2], sk_[2]; \
                _Pragma("unroll") for (int ks_ = 0; ks_ < 2; ++ks_) { sq_[ks_] = ldfrag(qrow_ + ks_ * 64); sk_[ks_] = ldfrag(krow_ + ks_ * 64); } \
                _Pragma("unroll") for (int ks_ = 0; ks_ < 8; ++ks_) { SCHED_FENCE(); s_ = MFMA16(sk_[ks_ & 1], sq_[ks_ & 1], s_); SCHED_FENCE(); \
                    if (ks_ + 2 < 8) { sq_[ks_ & 1] = ldfrag(qrow_ + (ks_ + 2) * 64); sk_[ks_ & 1] = ldfrag(krow_ + (ks_ + 2) * 64); } } \
                const int j0_ = sjb * 16 + 4 * fq; \
                _Pragma("unroll") for (int x_ = 0; x_ < 4; ++x_) { if (j0_ + x_ > sil) s_[x_] = 0.f; } } \
            u32x2 p_; p_.x = cvt_pk(s_[0], s_[1]); p_.y = cvt_pk(s_[2], s_[3]); \
            *(LAS u32x2*)(sb_ + C3_P + sil * C3_PROW + (sjb * 16 + 4 * fq) * 2) = p_; } } while (0)
        P1_LOAD(0, 0); P1_LOAD(1, 1); P1_WRITE(0, 0); P1_WRITE(1, 1);
        RAW_BAR();
        P1_LOAD(0, 2); P1_LOAD(1, 3);
        P1_SCORES(0);
        RAW_BAR();
        for (int n2 = 0; n2 < 64; n2 += 2) {
#pragma unroll
        for (int par = 0; par < 2; ++par) {
            const int n = n2 + par;
            const int cur = n % 3, nxt = (n + 1) % 3, fil = (n + 2) % 3;
            LAS unsigned char* sb = lds + cur * C3_SET;
            if (n + 2 < 64) { if (!(ABL & 8)) P1_WRITE(par, fil); else asm volatile("" :: "v"(pq[par][0]), "v"(pq[par][1]), "v"(pk[par][0]), "v"(pk[par][1]), "v"(pv[par])); }
            if (n > 0) {
                const u32x4 ov4 = *(const LAS u32x4*)(lds + C3_OST + ((n - 1) & 1) * (32 * C3_OROW) + ostr);
                __builtin_amdgcn_raw_buffer_store_b128(__builtin_bit_cast(v4u_t, ov4), Vg, ostg, (n - 1) * (32 * 4096), 0);
            }
            if (n + 4 < 64) P1_LOAD(par, n + 4);
            if (n + 1 < 64 && !(ABL & 1)) P1_SCORES(nxt);
            const bf16x8 vzf = ldtr2(sb + C3_VZ + (8 * fq + q4) * R_VROW + 32 * w + 8 * p4, 4 * R_VROW);
            f32x4 aP[2], aQ[2];
#pragma unroll
            for (int ib = 0; ib < 2; ++ib) { aP[ib] = (f32x4){0.f, 0.f, 0.f, 0.f}; aQ[ib] = (f32x4){0.f, 0.f, 0.f, 0.f}; }
            if (!(ABL & 2)) {
                bf16x8 pf[2], qb[2][2];
#pragma unroll
                for (int ib = 0; ib < 2; ++ib) { pf[ib] = ldfrag(sb + C3_P + (ib * 16 + fr) * C3_PROW + fq * 16);
                    const LAS unsigned char* qp = sb + C3_QS + (ib * 16 + fr) * R_ROW + (4 * fq) * 2; qb[0][ib] = ld2x64(qp, qp + 32); }
                SCHED_FENCE();
#pragma unroll
                for (int ib = 0; ib < 2; ++ib) aP[ib] = MFMA16(vzf, pf[ib], aP[ib]);
#pragma unroll
                for (int kq = 0; kq < 8; ++kq) {
                    if (kq < 7) {
#pragma unroll
                        for (int ib = 0; ib < 2; ++ib) { const LAS unsigned char* qp = sb + C3_QS + (ib * 16 + fr) * R_ROW + (32 * (kq + 1) + 4 * fq) * 2; qb[(kq + 1) & 1][ib] = ld2x64(qp, qp + 32); }
                    }
                    const bf16x8 af = state_frag(S[2 * kq], S[2 * kq + 1]);
                    SCHED_FENCE();
#pragma unroll
                    for (int ib = 0; ib < 2; ++ib) aQ[ib] = MFMA16(af, qb[kq & 1][ib], aQ[ib]);
                    SCHED_FENCE();
                }
            }
#pragma unroll
            for (int ib = 0; ib < 2; ++ib) { u32x2 o2; o2.x = cvt_pk(rs1[ib] * aP[ib][0] + xi[ib] * aQ[ib][0], rs1[ib] * aP[ib][1] + xi[ib] * aQ[ib][1]); o2.y = cvt_pk(rs1[ib] * aP[ib][2] + xi[ib] * aQ[ib][2], rs1[ib] * aP[ib][3] + xi[ib] * aQ[ib][3]);
                *(LAS u32x2*)(lds + C3_OST + (n & 1) * (32 * C3_OROW) + ib * 16 * C3_OROW + ostw) = o2; }
#pragma unroll
            for (int db = 0; db < 16; ++db) S[db] = S[db] * gC;
            if (!(ABL & 4)) {
                bf16x8 kf[2][4];
                const LAS unsigned char* kb = sb + C3_KS + (8 * fq + q4) * R_ROW + 8 * p4;
#pragma unroll
                for (int j = 0; j < 4; ++j) kf[0][j] = ldtr2(kb + 32 * j, 4 * R_ROW);
#pragma unroll
                for (int g = 0; g < 4; ++g) {
                    if (g < 3) {
#pragma unroll
                        for (int j = 0; j < 4; ++j) kf[(g + 1) & 1][j] = ldtr2(kb + 32 * (4 * (g + 1) + j), 4 * R_ROW);
                    }
                    SCHED_FENCE();
#pragma unroll
                    for (int j = 0; j < 4; ++j) S[4 * g + j] = MFMA16(kf[g & 1][j], vzf, S[4 * g + j]);
                    SCHED_FENCE();
                }
            }
            RAW_BAR();
        }
        }
        { const u32x4 ov4 = *(const LAS u32x4*)(lds + C3_OST + (63 & 1) * (32 * C3_OROW) + ostr);
          __builtin_amdgcn_raw_buffer_store_b128(__builtin_bit_cast(v4u_t, ov4), Vg, ostg, 63 * (32 * 4096), 0); }
        RAW_BAR();
        float* Lp = Lw + ((size_t)(item * 8 + w) * 16) * 256 + lane * 4;
#pragma unroll
        for (int db = 0; db < 16; ++db) *(f32x4*)(Lp + db * 256) = S[db];
#undef P1_LOAD
#undef P1_WRITE
#undef P1_SCORES
    }
}
template <int AB2> __device__ __forceinline__ void ret_pass2(Frame& F) {
    LAS unsigned char* lds = F.lds;
    const int tid = F.tid, lane = F.lane, w = F.wave, fr = lane & 15, fq = lane >> 4;
    const int srow = tid >> 5, sc16 = tid & 31;
    const float* Lw = (const float*)F.out;
    constexpr int QSET = 64 * R_ROW, NCH = 32, OST = 2 * QSET, OROW = 272;
    for (int u = F.vcu; u < 192; u += F.G) {
        const int it3 = u, slice = it3 & 3, sg = (it3 >> 2) % 3 + 1, bh = it3 / 12, b = bh >> 2, h = bh & 3;
        const float l2g = log2f(1.0f - exp2f(-5.0f - (float)h));
        const size_t tok0 = (size_t)b * SEQ + sg * 2048;
        const __amdgpu_buffer_rsrc_t Qg = RSRC(F.Q + tok0 * 1024 + h * 256), Vg = RSRC(F.V + tok0 * 2048 + h * 512 + slice * 128);
        unsigned oq[4], oo4[4];
#pragma unroll
        for (int i = 0; i < 4; ++i) { oq[i] = (unsigned)((srow + 16 * i) * 2048 + sc16 * 16); oo4[i] = (unsigned)((i * 16 + fr) * 4096 + (16 * w + 4 * fq) * 2); }
        const unsigned ostw = (unsigned)(fr * OROW + 32 * w + 8 * fq), ostr = (unsigned)((tid >> 4) * OROW + (tid & 15) * 16), ostg = (unsigned)((tid >> 4) * 4096 + (tid & 15) * 16);
        u32x4 pq[3][4]; u32x2 oo[3][4];
#define P2_LOADQ(c_) do { _Pragma("unroll") for (int i_ = 0; i_ < 4; ++i_) pq[(c_) % 3][i_] = BLD128(Qg, oq[i_], (c_) * (64 * 2048)); } while (0)
#define P2_LOADO(c_) do { _Pragma("unroll") for (int i_ = 0; i_ < 4; ++i_) oo[(c_) % 3][i_] = (AB2 & 2) ? (u32x2){0u, 0u} : BLD64(Vg, oo4[i_], (c_) * (64 * 4096)); } while (0)
#define P2_WRITEQ(c_) do { _Pragma("unroll") for (int i_ = 0; i_ < 4; ++i_) *(LAS u32x4*)(lds + ((c_) & 1) * QSET + (srow + 16 * i_) * R_ROW + sc16 * 16) = pq[(c_) % 3][i_]; } while (0)
        P2_LOADQ(0); P2_LOADQ(1); P2_LOADQ(2); P2_LOADO(0); P2_LOADO(1); P2_LOADO(2);
        f32x4 T[16];
#pragma unroll
        for (int i = 0; i < 16; ++i) T[i] = (f32x4){0.f, 0.f, 0.f, 0.f};
        for (int m = 0; m < ((AB2 & 4) ? 0 : sg); ++m) {
            const float coef = exp2f(2048.0f * (float)(sg - 1 - m) * l2g);
            const float* Lp = Lw + ((size_t)(((bh << 4) | (m << 2) | slice) * 8 + w) * 16) * 256 + lane * 4;
#pragma unroll
            for (int db = 0; db < 16; ++db) T[db] = T[db] + *(const f32x4*)(Lp + db * 256) * coef;
        }
        bf16x8 af8[8];
#pragma unroll
        for (int kq = 0; kq < 8; ++kq) af8[kq] = state_frag(T[2 * kq], T[2 * kq + 1]);
        P2_WRITEQ(0);
        RAW_BAR();
        for (int n3 = 0; n3 < NCH + 1; n3 += 3) {
#pragma unroll
        for (int par = 0; par < 3; ++par) {
            const int n = n3 + par;
            if (n < NCH) {
            const LAS unsigned char* sb = lds + (n & 1) * QSET;
            if (n + 1 < NCH) {
#pragma unroll
                for (int i = 0; i < 4; ++i) { if (AB2 & 8) asm volatile("" :: "v"(pq[(par + 1) % 3][i])); else *(LAS u32x4*)(lds + ((n + 1) & 1) * QSET + (srow + 16 * i) * R_ROW + sc16 * 16) = pq[(par + 1) % 3][i]; }
            }
            if (n > 0 && !(AB2 & 2)) {
#pragma unroll
                for (int i = 0; i < 2; ++i) { const u32x4 ov4 = *(const LAS u32x4*)(lds + OST + ((n - 1) & 1) * (64 * OROW) + i * 32 * OROW + ostr);
                    __builtin_amdgcn_raw_buffer_store_b128(__builtin_bit_cast(v4u_t, ov4), Vg, ostg + i * (32 * 4096), (n - 1) * (64 * 4096), 0); }
            }
            f32x4 aQ[4];
#pragma unroll
            for (int ib = 0; ib < 4; ++ib) aQ[ib] = (f32x4){0.f, 0.f, 0.f, 0.f};
            if (!(AB2 & 1)) {
                bf16x8 qb[2][4];
#pragma unroll
                for (int ib = 0; ib < 4; ++ib) { const LAS unsigned char* qp = sb + (ib * 16 + fr) * R_ROW + (4 * fq) * 2; qb[0][ib] = ld2x64(qp, qp + 32); }
#pragma unroll
                for (int kq = 0; kq < 8; ++kq) {
                    if (kq < 7) {
#pragma unroll
                        for (int ib = 0; ib < 4; ++ib) { const LAS unsigned char* qp = sb + (ib * 16 + fr) * R_ROW + (32 * (kq + 1) + 4 * fq) * 2; qb[(kq + 1) & 1][ib] = ld2x64(qp, qp + 32); }
                    }
                    SCHED_FENCE();
#pragma unroll
                    for (int ib = 0; ib < 4; ++ib) aQ[ib] = MFMA16(af8[kq], qb[kq & 1][ib], aQ[ib]);
                    SCHED_FENCE();
                }
            }
#pragma unroll
            for (int ib = 0; ib < 4; ++ib) { const float x = exp2f((float)(n * 64 + ib * 16 + fr + 1) * l2g); const u32x2 o0 = oo[par][ib];
                u32x2 r2; r2.x = cvt_pk(bf_lo(o0.x) + x * aQ[ib][0], bf_hi(o0.x) + x * aQ[ib][1]); r2.y = cvt_pk(bf_lo(o0.y) + x * aQ[ib][2], bf_hi(o0.y) + x * aQ[ib][3]);
                *(LAS u32x2*)(lds + OST + (n & 1) * (64 * OROW) + ib * 16 * OROW + ostw) = r2; }
            if (n + 3 < NCH) {
#pragma unroll
                for (int i = 0; i < 4; ++i) { pq[par][i] = BLD128(Qg, oq[i], (n + 3) * (64 * 2048)); oo[par][i] = (AB2 & 2) ? (u32x2){0u, 0u} : BLD64(Vg, oo4[i], (n + 3) * (64 * 4096)); }
            }
            RAW_BAR();
            }
        }
        }
#pragma unroll
        for (int i = 0; i < 2; ++i) { const u32x4 ov4 = *(const LAS u32x4*)(lds + OST + ((NCH - 1) & 1) * (64 * OROW) + i * 32 * OROW + ostr);
            __builtin_amdgcn_raw_buffer_store_b128(__builtin_bit_cast(v4u_t, ov4), Vg, ostg + i * (32 * 4096), (NCH - 1) * (64 * 4096), 0); }
        RAW_BAR();
#undef P2_LOADQ
#undef P2_LOADO
#undef P2_WRITEQ
    }
}
__device__ __forceinline__ void gn_pass(Frame& F, bool dry) {
    const int gw = F.vcu * 8 + F.wave, NGW = F.G * 8;
    for (int t0 = gw * 2; t0 < M; t0 += NGW * 2) {
        u32x4 o[8], z[8];
#pragma unroll
        for (int q = 0; q < 8; ++q) { const size_t off = (size_t)(t0 + (q >> 2)) * 2048 + (q & 3) * 512 + F.lane * 8; o[q] = *(const u32x4*)(F.V + off); z[q] = *(const u32x4*)(F.ZR + off); }
        float v[8][8], s[8];
#pragma unroll
        for (int q = 0; q < 8; ++q) { v[q][0] = bf_lo(o[q].x); v[q][1] = bf_hi(o[q].x); v[q][2] = bf_lo(o[q].y); v[q][3] = bf_hi(o[q].y); v[q][4] = bf_lo(o[q].z); v[q][5] = bf_hi(o[q].z); v[q][6] = bf_lo(o[q].w); v[q][7] = bf_hi(o[q].w);
            s[q] = ((v[q][0] + v[q][1]) + (v[q][2] + v[q][3])) + ((v[q][4] + v[q][5]) + (v[q][6] + v[q][7])); }
#pragma unroll
        for (int q = 0; q < 8; ++q) s[q] = wave_sum(s[q]) * (1.0f / 512.0f);
#pragma unroll
        for (int q = 0; q < 8; ++q) { float a = 0.f;
#pragma unroll
            for (int i = 0; i < 8; ++i) { v[q][i] -= s[q]; a += v[q][i] * v[q][i]; }
            s[q] = a; }
#pragma unroll
        for (int q = 0; q < 8; ++q) s[q] = rsqrtf(wave_sum(s[q]) * (1.0f / 512.0f) + 1e-5f);
#pragma unroll
        for (int q = 0; q < 8; ++q) { const size_t off = (size_t)(t0 + (q >> 2)) * 2048 + (q & 3) * 512 + F.lane * 8; const float rs = s[q];
            u32x4 r; r.x = cvt_pk(v[q][0] * rs * fsilu(bf_lo(z[q].x)), v[q][1] * rs * fsilu(bf_hi(z[q].x))); r.y = cvt_pk(v[q][2] * rs * fsilu(bf_lo(z[q].y)), v[q][3] * rs * fsilu(bf_hi(z[q].y)));
            r.z = cvt_pk(v[q][4] * rs * fsilu(bf_lo(z[q].z)), v[q][5] * rs * fsilu(bf_hi(z[q].z))); r.w = cvt_pk(v[q][6] * rs * fsilu(bf_lo(z[q].w)), v[q][7] * rs * fsilu(bf_hi(z[q].w)));
            if (dry) *(u32x4*)(F.H + (off & (size_t)(32u * 1024u * 1024u - 1u))) = r; else *(u32x4*)(F.ZR + off) = r; }
    }
}
__device__ __forceinline__ void conv_pass(Frame& F) {
    LAS float* cv = (LAS float*)F.lds;
    const int t = F.tid, c0 = 2 * t, lane = F.lane, w = F.wave;
    float w0[31], w1[31];
#pragma unroll
    for (int k = 0; k < 31; ++k) { const f32x2v wv = *(const f32x2v*)(F.conv_w + k * 1024 + c0); w0[k] = wv.x; w1[k] = wv.y; }
    const f32x2v cb = *(const f32x2v*)(F.conv_b + c0);
    const bf16* A = F.Q;
    const bf16* ZC = F.K;
    for (int tile = F.vcu; tile < M / 128; tile += F.G) {
        const int tok0 = tile * 128, b = tok0 / SEQ, s0 = tok0 % SEQ;
        const bf16* Ab = A + (size_t)b * SEQ * 1024 + c0;
        float in0[38], in1[38];
#pragma unroll
        for (int i = 0; i < 38; ++i) { const int s = s0 - 30 + i; const int sc = s < 0 ? 0 : s;
            unsigned uu = *(const unsigned*)(Ab + (size_t)sc * 1024); if (s < 0) uu = 0u; in0[i] = bf_lo(uu); in1[i] = bf_hi(uu); }
        for (int g32 = 0; g32 < 4; ++g32) {
            u32x2 zz[4][4];
#pragma unroll
            for (int q = 0; q < 4; ++q)
#pragma unroll
                for (int j = 0; j < 4; ++j) zz[q][j] = *(const u32x2*)(ZC + (size_t)(tok0 + 32 * g32 + 4 * w + q) * 1024 + 4 * lane + 256 * j);
            for (int sub = 0; sub < 4; ++sub) {
                const int gi = 4 * g32 + sub, sf = s0 + 8 * gi;
                unsigned nx[8];
#pragma unroll
                for (int i = 0; i < 8; ++i) { const int sn = (gi < 15) ? sf + 8 + i : sf + i; nx[i] = *(const unsigned*)(Ab + (size_t)sn * 1024); }
#pragma unroll
                for (int j = 0; j < 8; ++j) { float x0 = cb.x, x1 = cb.y;
#pragma unroll
                    for (int k = 0; k < 31; ++k) { x0 = fmaf(w0[k], in0[j + k], x0); x1 = fmaf(w1[k], in1[j + k], x1); }
                    *(LAS f32x2v*)(cv + (8 * sub + j) * 1024 + c0) = (f32x2v){x0, x1}; }
#pragma unroll
                for (int i = 0; i < 30; ++i) { in0[i] = in0[i + 8]; in1[i] = in1[i + 8]; }
#pragma unroll
                for (int i = 0; i < 8; ++i) { in0[30 + i] = bf_lo(nx[i]); in1[30 + i] = bf_hi(nx[i]); }
            }
            RAW_BAR();
#pragma unroll
            for (int q = 0; q < 4; ++q) {
                const int tk = 4 * w + q;
                f32x4 v[4]; float s = 0.f, s2 = 0.f;
#pragma unroll
                for (int j = 0; j < 4; ++j) { v[j] = *(const LAS f32x4*)(cv + tk * 1024 + 4 * lane + 256 * j); s += (v[j][0] + v[j][1]) + (v[j][2] + v[j][3]); }
                const float mean = wave_sum(s) * (1.0f / 1024.0f);
#pragma unroll
                for (int j = 0; j < 4; ++j) { v[j] = v[j] - mean; s2 += (v[j][0] * v[j][0] + v[j][1] * v[j][1]) + (v[j][2] * v[j][2] + v[j][3] * v[j][3]); }
                const float rstd = rsqrtf(wave_sum(s2) * (1.0f / 1024.0f) + 1e-5f);
                bf16* orow = F.H + (size_t)(tok0 + 32 * g32 + tk) * 1024 + 4 * lane;
#pragma unroll
                for (int j = 0; j < 4; ++j) { const f32x4 lg = *(const f32x4*)(F.ln_g + 4 * lane + 256 * j), lb = *(const f32x4*)(F.ln_b + 4 * lane + 256 * j);
                    const f32x4 y = v[j] * rstd * lg + lb;
                    u32x2 o; o.x = cvt_pk(fsilu(y[0]) * fsilu(bf_lo(zz[q][j].x)), fsilu(y[1]) * fsilu(bf_hi(zz[q][j].x))); o.y = cvt_pk(fsilu(y[2]) * fsilu(bf_lo(zz[q][j].y)), fsilu(y[3]) * fsilu(bf_hi(zz[q][j].y)));
                    *(u32x2*)(orow + 256 * j) = o; }
            }
            RAW_BAR();
        }
    }
    __syncthreads();
}
__device__ __forceinline__ void phase8(Frame& F) {
    const int gw = F.vcu * 8 + F.wave, NGW = F.G * 8;
    const __amdgpu_buffer_rsrc_t ry = RSRC(F.YB), rx = RSRC(F.x), ro = RSRC(F.out);
    const unsigned vy = (unsigned)F.lane * 8u, vx = (unsigned)F.lane * 16u;
    const float poison = (__hip_atomic_load(F.ctl + CW_BAR + XB_TMO, __ATOMIC_RELAXED, __HIP_MEMORY_SCOPE_AGENT) != 0u) ? __builtin_nanf("") : 0.0f;
    for (int rb = gw; rb < M / 16; rb += NGW) {
        const int b = (rb * 16) / SEQ;
        f32x4 cg[4];
#pragma unroll
        for (int j = 0; j < 4; ++j) { const int col = 4 * F.lane + 256 * j; cg[j] = *(const f32x4*)(F.post_g + col) * *(const f32x4*)(F.mod + b * 3072 + 2048 + col); }
        for (int r = 0; r < 16; r += 4) {
            const int m = rb * 16 + r;
            u32x2 yy[4][4]; f32x4 xv[4][4]; float ss[4];
#pragma unroll
            for (int q = 0; q < 4; ++q)
#pragma unroll
                for (int j = 0; j < 4; ++j) yy[q][j] = BLD64(ry, vy + 512u * j, (m + q) * 2048);
#pragma unroll
            for (int q = 0; q < 4; ++q)
#pragma unroll
                for (int j = 0; j < 4; ++j) xv[q][j] = __builtin_bit_cast(f32x4, BLD128(rx, vx + 1024u * j, (m + q) * 4096));
#pragma unroll
            for (int q = 0; q < 4; ++q) { float s = 0.f;
#pragma unroll
                for (int j = 0; j < 4; ++j) { const float a = bf_lo(yy[q][j].x), b2 = bf_hi(yy[q][j].x), c = bf_lo(yy[q][j].y), e = bf_hi(yy[q][j].y); s += (a * a + b2 * b2) + (c * c + e * e); }
                ss[q] = s; }
#pragma unroll
            for (int q = 0; q < 4; ++q) ss[q] = wave_sum(ss[q]);
#pragma unroll
            for (int q = 0; q < 4; ++q) { const float rstd = rsqrtf(ss[q] * (1.0f / D) + 1e-6f);
#pragma unroll
                for (int j = 0; j < 4; ++j) { const f32x4 v = (f32x4){bf_lo(yy[q][j].x), bf_hi(yy[q][j].x), bf_lo(yy[q][j].y), bf_hi(yy[q][j].y)}; const f32x4 o = xv[q][j] + v * rstd * cg[j] + poison;
                    __builtin_amdgcn_raw_buffer_store_b128(__builtin_bit_cast(v4u_t, o), ro, vx + 1024u * j, (m + q) * 4096, 0); } }
        }
    }
}

struct Args { const float* in[15]; float* out; unsigned char* ws; int ph_lo, ph_hi; };
#ifndef MK_TWICE
#define MK_TWICE 0
#endif
#define REP(k) for (int rep_ = ((MK_TWICE >> (k)) & 1); rep_ >= 0; --rep_)
#define DRY ((bool)(rep_ > 0))
__global__ void __launch_bounds__(512, 2) mk_fwd(Args args) {
    extern __shared__ __attribute__((aligned(16))) unsigned char lds_raw[];
    Frame F;
    F.lds = (LAS unsigned char*)lds_raw;
    F.MISC = (volatile LAS unsigned*)(F.lds + MISC_OFF);
    F.tid = threadIdx.x; F.lane = F.tid & 63; F.wave = __builtin_amdgcn_readfirstlane(F.tid >> 6);
    F.G = gridDim.x; { const int bx = blockIdx.x; F.vcu = (F.G % 8 == 0) ? (bx % 8) * (F.G / 8) + bx / 8 : bx; }
    unsigned char* ws = args.ws;
    F.ctl = (unsigned*)(ws + WS_CTL);
    F.x = args.in[0]; F.c = args.in[1]; F.pos = (const int*)args.in[2]; F.w_ada = args.in[3]; F.b_ada = args.in[4]; F.pre_g = args.in[5]; F.w_in = args.in[6];
    F.conv_w = args.in[7]; F.conv_b = args.in[8]; F.ln_g = args.in[9]; F.ln_b = args.in[10]; F.w_ret = args.in[11]; F.w_conv = args.in[12]; F.w_out = args.in[13]; F.post_g = args.in[14];
    F.out = args.out; F.mod = (float*)(ws + WS_MOD);
    F.WIN = (bf16*)(ws + WS_WIN); F.WRET = (bf16*)(ws + WS_WRET); F.WCONV = (bf16*)(ws + WS_WCONV); F.WOUT = (bf16*)(ws + WS_WOUT);
    F.H = (bf16*)(ws + WS_H); F.Q = (bf16*)(ws + WS_Q); F.K = (bf16*)(ws + WS_K); F.V = (bf16*)(ws + WS_V); F.ZR = (bf16*)(ws + WS_ZR);
    F.SGA = (bf16*)args.out; F.SGB = (bf16*)args.out + (size_t)M * 1024; F.F32S = (float*)(ws + WS_V); F.YB = (bf16*)(ws + WS_K);
    for (int u = F.tid; u < (LDS_BYTES - LDSCTL_OFF) / 4; u += 512) ((LAS unsigned*)(F.lds + LDSCTL_OFF))[u] = 0u;
    __syncthreads();
    const int lo = args.ph_lo, hi = args.ph_hi;
    XcdBarrier bar; bar.bar = (unsigned*)(F.ctl + CW_BAR); bar.x = 0; bar.st = nullptr;
    if (hi - lo > 1) bar = xcd_barrier_post((unsigned*)(F.ctl + CW_BAR), F.MISC + 8);
#ifndef MK_STAG_GROUPS
#define MK_STAG_GROUPS 8
#define MK_STAG_TICKS 350
#endif
#define STAGGER_T(ticks) do { const unsigned long long t0_ = __builtin_amdgcn_s_memrealtime(); const unsigned long long dl_ = (unsigned long long)(F.vcu % MK_STAG_GROUPS) * (ticks); \
        while (__builtin_amdgcn_s_memrealtime() - t0_ < dl_) __builtin_amdgcn_s_sleep(8); } while (0)
#define IN(k) (lo <= (k) && (k) < hi)
#define SEAM(k) do { if (IN(k) && IN((k) + 1)) xcd_barrier(bar); } while (0)
    if (IN(0)) { phase0(F); } SEAM(0);
    if (IN(1)) { phase1(F); } SEAM(1);
    if (IN(2)) {
        pg8::Gemm g{F.H, F.WIN, M, NT1 * 256, 1024}; pg8::StaticOrder S; S.init(M, NT1 * 256, F.G, (int)blockIdx.x);
        EpiProj1 E{F.Q, F.K, F.V, F.ZR, F.pos};
        pg8::gemm_phase<EpiProj1, pg8::StaticOrder, true, true>(F.lds, g, S, E);
    } SEAM(2);
    if (IN(3)) { ret_pass1<0>(F); } SEAM(3);
    if (IN(4)) { ret_pass2<0>(F); } SEAM(4);
    if (IN(5)) {
        pg8::Gemm g{F.H, F.WIN + (size_t)NT1 * 256 * 1024, M, NT2 * 256, 1024}; pg8::StaticOrder S; S.init(M, NT2 * 256, F.G, (int)blockIdx.x);
        EpiProj2 E{F.Q, F.K, F.SGA, F.SGB};
#ifdef MK_STAG5
        STAGGER_T(MK_STAG5);
#endif
        pg8::gemm_phase<EpiProj2, pg8::StaticOrder, true, true>(F.lds, g, S, E);
    } SEAM(5);
    if (IN(6)) { gn_pass(F, false); conv_pass(F); } SEAM(6);
    if (IN(7)) {
        pg8::StaticOrder S; S.init(M, 1024, F.G, (int)blockIdx.x);
        const bool swp = (F.vcu & 1) != 0;
        pg8::Gemm2 g{swp ? F.H : F.ZR, swp ? F.WCONV : F.WRET, swp ? 1024 : 2048, swp ? F.ZR : F.H, swp ? F.WRET : F.WCONV, swp ? 2048 : 1024, M, 1024};
        EpiMerge E{swp ? F.SGB : F.SGA, swp ? F.SGA : F.SGB, F.Q};
        pg8::gemm_phase2<EpiMerge, pg8::StaticOrder>(F.lds, g, S, E);
    } SEAM(7);
    if (IN(8)) {
        pg8::Gemm g{F.Q, F.WOUT, M, 1024, 1024}; pg8::StaticOrder S; S.init(M, 1024, F.G, (int)blockIdx.x);
        EpiY E{F.YB};
        pg8::gemm_phase<EpiY, pg8::StaticOrder, true, true>(F.lds, g, S, E);
    } SEAM(8);
    if (IN(9)) { phase8(F); }
#ifdef MK_P2ABL
    if (IN(13)) { ret_pass2<MK_P2ABL>(F); }
#endif
#ifdef MK_NULLEPI
    if (IN(11)) {
        pg8::Gemm g{F.H, F.WIN, M, NT1 * 256, 1024}; pg8::StaticOrder S; S.init(M, NT1 * 256, F.G, (int)blockIdx.x);
        EpiNull E{};
        pg8::gemm_phase<EpiNull, pg8::StaticOrder, true, true>(F.lds, g, S, E);
    }
#endif
#ifdef MK_ABL
    if (IN(10)) { ret_pass1<MK_ABL>(F); }
#endif
#undef IN
#undef SEAM
}


__global__ void mk_dump(const unsigned char* ws, float* out, int which) {
    const size_t i = (size_t)blockIdx.x * blockDim.x + threadIdx.x;
    if (i >= (size_t)M * 1024) return;
    const size_t m = i >> 10, c = i & 1023;
    const bf16* Q = (const bf16*)(ws + WS_Q); const bf16* K = (const bf16*)(ws + WS_K); const bf16* V = (const bf16*)(ws + WS_V); const bf16* ZR = (const bf16*)(ws + WS_ZR); const bf16* H = (const bf16*)(ws + WS_H);
    float r = 0.f;
    auto f = [](bf16 v) { return __uint_as_float(((unsigned)v) << 16); };
    if (which == 0) r = f(H[i]);
    if (which == 1) r = f(Q[i]) + f(K[i]) + f(V[m * 2048 + c]) + f(V[m * 2048 + 1024 + c]) + f(ZR[m * 2048 + c]) + f(ZR[m * 2048 + 1024 + c]);
    if (which == 2) r = f(V[m * 2048 + c]) + f(V[m * 2048 + 1024 + c]);
    if (which == 3) r = f(Q[i]) + f(K[i]);
    if (which == 4) r = f(K[i]) + f(ZR[m * 2048 + c]) + f(ZR[m * 2048 + 1024 + c]);
    if (which == 5) r = f(H[i]);
    if (which == 6) r = ((const float*)(ws + WS_V))[i];
    out[i] = r;
}
#ifndef MK_SPLIT
#define MK_SPLIT 0
#endif
extern "C" void kernel_launch(void* const* d_in, const int* in_sizes, int n_in, void* d_out, int out_size, void* d_ws, size_t ws_size, hipStream_t stream) {
    static int grid = 0;
    if (grid == 0) {
        if (n_in != 15 || in_sizes[0] != M * D || out_size != M * D || ws_size < WS_END) { fprintf(stderr, "kernel_launch: unexpected shapes (n_in %d, in0 %d, out %d, ws %zu)\n", n_in, n_in > 0 ? in_sizes[0] : -1, out_size, ws_size); grid = -1; return; }
        int dev = 0, cus = 0;
        if (hipGetDevice(&dev) != hipSuccess || hipDeviceGetAttribute(&cus, hipDeviceAttributeMultiprocessorCount, dev) != hipSuccess) { grid = -1; return; }
        if (hipFuncSetAttribute((const void*)mk_fwd, hipFuncAttributeMaxDynamicSharedMemorySize, LDS_BYTES) != hipSuccess) { fprintf(stderr, "kernel_launch: hipFuncSetAttribute failed\n"); grid = -1; return; }
        grid = cus;
    }
    if (grid < 0) return;
    (void)hipMemsetAsync((char*)d_ws + WS_CTL, 0, CTL_BYTES, stream);
    Args a{};
    for (int i = 0; i < 15; ++i) a.in[i] = (const float*)d_in[i];
    a.out = (float*)d_out; a.ws = (unsigned char*)d_ws;
#if MK_SPLIT
#ifdef MK_DUMP_AFTER
    for (int p = 0; p <= MK_DUMP_AFTER; ++p) { a.ph_lo = p; a.ph_hi = p + 1; hipLaunchKernelGGL(mk_fwd, dim3(grid), dim3(512), LDS_BYTES, stream, a); }
    hipLaunchKernelGGL(mk_dump, dim3(M * 1024 / 256), dim3(256), 0, stream, (const unsigned char*)d_ws, (float*)d_out, MK_DUMP_WHICH);
#else
    for (int p = 0; p < NPHASE; ++p) { a.ph_lo = p; a.ph_hi = p + 1; hipLaunchKernelGGL(mk_fwd, dim3(grid), dim3(512), LDS_BYTES, stream, a); }
#endif
#else
#ifdef MK_PRE_LO
    a.ph_lo = MK_PRE_LO; a.ph_hi = MK_PRE_HI; hipLaunchKernelGGL(mk_fwd, dim3(grid), dim3(512), LDS_BYTES, stream, a);
#endif
    a.ph_lo = 0; a.ph_hi = NPHASE; hipLaunchKernelGGL(mk_fwd, dim3(grid), dim3(512), LDS_BYTES, stream, a);
#ifdef MK_EXTRA_LO
    a.ph_lo = MK_EXTRA_LO; a.ph_hi = MK_EXTRA_HI; hipLaunchKernelGGL(mk_fwd, dim3(grid), dim3(512), LDS_BYTES, stream, a);
#endif
#endif
}
```
